# Optimizing an MI355X kernel written in HIP

```python
import jax, jax.numpy as jnp
from jax import lax
import numpy as np

D_MODEL = 1024
BATCH = 4
SEQ = 8192
DEPTH = 1

D_MIX = D_MODEL
D_CONV = D_MIX // 2
CONV_GROUPS = 8
CONV_WIDTH = 3
D_RWKV = D_MIX - D_CONV
RWKV_HEAD = 64
RWKV_HEADS = D_RWKV // RWKV_HEAD
DECAY_LORA = 64
AAA_LORA = 64
GATE_LORA = 128
N_DIR = 2
D_FF = 2816
N_LAYER_MOD = 9
RMS_EPS = 1e-6
GN_EPS = 64e-5
L2_EPS = 1e-12
MACARON = 0.5
RWKV_COLS = 3 * D_RWKV + DECAY_LORA + AAA_LORA + GATE_LORA
W_IN_COLS = 3 * D_CONV + RWKV_COLS

kernel_name = "hybrid_conv_rwkv7_macaron_adaln"


def rmsnorm(x, g):
    xf = x.astype(jnp.float32)
    y = xf * lax.rsqrt(jnp.mean(xf * xf, axis=-1, keepdims=True) + RMS_EPS)
    return (y * g.astype(jnp.float32)).astype(x.dtype)


def modulate(x, g, shift, scale):
    return rmsnorm(x, g) * (1.0 + scale[:, None, :]) + shift[:, None, :]


def swiglu(h, w_gate, w_up, w_down):
    a = jnp.einsum('btd,df->btf', h, w_gate)
    b = jnp.einsum('btd,df->btf', h, w_up)
    return jnp.einsum('btf,fd->btd', jax.nn.silu(a) * b, w_down)


def short_conv(u, conv_w, conv_b):
    C = u.shape[-1]
    rhs = conv_w.reshape(CONV_WIDTH, 1, C)
    pad = (CONV_WIDTH - 1) // 2
    y = lax.conv_general_dilated(u, rhs, window_strides=(1,), padding=((pad, pad),),
                                 dimension_numbers=('NWC', 'WIO', 'NWC'),
                                 feature_group_count=C)
    return y + conv_b


def centred_token_shift(u, mu):
    prev = jnp.pad(u, ((0, 0), (1, 0), (0, 0)))[:, :-1]
    nxt = jnp.pad(u, ((0, 0), (0, 1), (0, 0)))[:, 1:]
    return u + mu * (0.5 * (prev + nxt) - u)


def _heads(t):
    return t.reshape(t.shape[:-1] + (RWKV_HEADS, RWKV_HEAD))


def _dir_shared(t):
    s = jnp.stack([t, jnp.flip(t, axis=1)], axis=0)
    return jnp.moveaxis(s, 2, 0)


def _dir_own(t):
    s = jnp.stack([t[0], jnp.flip(t[1], axis=1)], axis=0)
    return jnp.moveaxis(s, 2, 0)


def _rwkv7_step(S, inp):
    r_t, w_t, k_t, v_t, kk_t, kka_t = inp
    sa = jnp.einsum('dbhvk,dbhk->dbhv', S, kk_t)
    S = (S * w_t[..., None, :] - sa[..., None] * kka_t[..., None, :]
         + v_t[..., None] * k_t[..., None, :])
    y = jnp.einsum('dbhvk,dbhk->dbhv', S, r_t)
    return S, y


def rwkv7_bidir(u, mu, w0, w_up, a0, a_up, g_up, k_k, k_a, r_k, gn_w, gn_b):
    f32 = jnp.float32
    Bsz, T, _ = u.shape
    u = centred_token_shift(u, mu)
    s1, s2, s3 = D_RWKV, 2 * D_RWKV, 3 * D_RWKV
    s4, s5 = s3 + DECAY_LORA, s3 + DECAY_LORA + AAA_LORA
    r, k, v, xw, xa, xg = jnp.split(u, [s1, s2, s3, s4, s5], axis=-1)
    r, k, v = r.astype(f32), k.astype(f32), v.astype(f32)
    z = w0.astype(f32)[:, None, None, :] + jnp.einsum(
        'btl,dlc->dbtc', jnp.tanh(xw), w_up).astype(f32)
    w = jnp.exp(-jnp.exp(-jax.nn.softplus(-z) - 0.5))
    a = jax.nn.sigmoid(a0.astype(f32)[:, None, None, :] + jnp.einsum(
        'btl,dlc->dbtc', xa, a_up).astype(f32))
    g = jnp.einsum('btl,lc->btc', jax.nn.sigmoid(xg), g_up).astype(f32)
    kk = _heads(k * k_k.astype(f32))
    kk = kk * lax.rsqrt(jnp.sum(kk * kk, axis=-1, keepdims=True) + L2_EPS)
    k_d = k[None] * (1.0 + (a - 1.0) * k_a.astype(f32))
    a_h, k_dh = _heads(a), _heads(k_d)
    r_h, v_h = _heads(r), _heads(v)
    xs = (_dir_shared(r_h), _dir_own(_heads(w)), _dir_own(k_dh), _dir_shared(v_h),
          _dir_shared(kk), _dir_own(kk[None] * a_h))
    S0 = jnp.zeros((N_DIR, Bsz, RWKV_HEADS, RWKV_HEAD, RWKV_HEAD), f32)
    _, ys = lax.scan(_rwkv7_step, S0, xs)
    ys = jnp.moveaxis(ys, 0, 2)
    y = ys[0] + jnp.flip(ys[1], axis=1)
    mean = jnp.mean(y, axis=-1, keepdims=True)
    var = jnp.mean(jnp.square(y - mean), axis=-1, keepdims=True)
    y = ((y - mean) * lax.rsqrt(var + GN_EPS)).reshape(Bsz, T, D_RWKV)
    y = y * gn_w.astype(f32) + gn_b.astype(f32)
    bonus = jnp.sum(r_h[None] * k_dh * _heads(r_k.astype(f32)), axis=(0, -1))[..., None] * v_h
    y = (y + bonus.reshape(Bsz, T, D_RWKV)) * g
    return y.astype(u.dtype)


def setup_inputs(seed: int = 0) -> dict:
    key = jax.random.key(seed)
    ks = iter(jax.random.split(key, 40))
    nrm = lambda shape, s: jax.random.normal(next(ks), shape, jnp.float32) * s
    L, D, F = DEPTH, D_MODEL, D_FF
    gain = lambda shape: 1.0 + nrm(shape, 0.02)
    return {
        "x": nrm((BATCH, SEQ, D), 1.0),
        "c": nrm((BATCH, D), 1.0),
        "ada_w": nrm((L, D, N_LAYER_MOD * D), 0.5 * D ** -0.5),
        "ada_b": nrm((L, N_LAYER_MOD * D), 0.02),
        "ffn1_norm": gain((L, D)),
        "ffn1_w_gate": nrm((L, D, F), D ** -0.5),
        "ffn1_w_up": nrm((L, D, F), D ** -0.5),
        "ffn1_w_down": nrm((L, F, D), F ** -0.5),
        "mix_norm": gain((L, D)),
        "w_in": nrm((L, D, W_IN_COLS), D ** -0.5),
        "conv_w": nrm((L, CONV_WIDTH, D_CONV), CONV_WIDTH ** -0.5),
        "conv_b": nrm((L, D_CONV), 0.02),
        "rwkv_mu": jax.random.uniform(next(ks), (L, RWKV_COLS), jnp.float32),
        "rwkv_w0": jax.random.uniform(next(ks), (L, N_DIR, D_RWKV), jnp.float32, -6.0, 1.0),
        "rwkv_w_up": nrm((L, N_DIR, DECAY_LORA, D_RWKV), 0.1 * DECAY_LORA ** -0.5),
        "rwkv_a0": nrm((L, N_DIR, D_RWKV), 0.1),
        "rwkv_a_up": nrm((L, N_DIR, AAA_LORA, D_RWKV), 0.1 * AAA_LORA ** -0.5),
        "rwkv_g_up": nrm((L, GATE_LORA, D_RWKV), GATE_LORA ** -0.5),
        "rwkv_k_k": 0.85 + nrm((L, D_RWKV), 0.02),
        "rwkv_k_a": 1.0 + nrm((L, D_RWKV), 0.02),
        "rwkv_r_k": nrm((L, D_RWKV), 0.1),
        "rwkv_gn_w": gain((L, D_RWKV)),
        "rwkv_gn_b": nrm((L, D_RWKV), 0.02),
        "w_out": nrm((L, D_MIX, D), D_MIX ** -0.5),
        "ffn2_norm": gain((L, D)),
        "ffn2_w_gate": nrm((L, D, F), D ** -0.5),
        "ffn2_w_up": nrm((L, D, F), D ** -0.5),
        "ffn2_w_down": nrm((L, F, D), F ** -0.5),
        "final_ada_w": nrm((D, 2 * D), 0.5 * D ** -0.5),
        "final_ada_b": nrm((2 * D,), 0.02),
        "final_norm": gain((D,)),
    }


def reference(x, c, ada_w, ada_b, ffn1_norm, ffn1_w_gate, ffn1_w_up, ffn1_w_down,
              mix_norm, w_in, conv_w, conv_b, rwkv_mu, rwkv_w0, rwkv_w_up, rwkv_a0,
              rwkv_a_up, rwkv_g_up, rwkv_k_k, rwkv_k_a, rwkv_r_k, rwkv_gn_w, rwkv_gn_b,
              w_out, ffn2_norm, ffn2_w_gate, ffn2_w_up, ffn2_w_down,
              final_ada_w, final_ada_b, final_norm):
    c_act = jax.nn.silu(c)
    for l in range(DEPTH):
        mod = jnp.einsum('bd,dm->bm', c_act, ada_w[l]) + ada_b[l]
        sh1, sc1, gt1, sh2, sc2, gt2, sh3, sc3, gt3 = jnp.split(mod, N_LAYER_MOD, axis=-1)
        h = modulate(x, ffn1_norm[l], sh1, sc1)
        x = x + MACARON * gt1[:, None, :] * swiglu(h, ffn1_w_gate[l], ffn1_w_up[l], ffn1_w_down[l])
        h = modulate(x, mix_norm[l], sh2, sc2)
        proj = jnp.einsum('btd,dk->btk', h, w_in[l])
        cb, cc, cx, ru = jnp.split(proj, [D_CONV, 2 * D_CONV, 3 * D_CONV], axis=-1)
        y_conv = cb * short_conv(cc * cx, conv_w[l], conv_b[l])
        y_rwkv = rwkv7_bidir(ru, rwkv_mu[l], rwkv_w0[l], rwkv_w_up[l], rwkv_a0[l],
                             rwkv_a_up[l], rwkv_g_up[l], rwkv_k_k[l], rwkv_k_a[l],
                             rwkv_r_k[l], rwkv_gn_w[l], rwkv_gn_b[l])
        y = jnp.einsum('btk,kd->btd', jnp.concatenate([y_conv, y_rwkv], axis=-1), w_out[l])
        x = x + gt2[:, None, :] * y
        h = modulate(x, ffn2_norm[l], sh3, sc3)
        x = x + MACARON * gt3[:, None, :] * swiglu(h, ffn2_w_gate[l], ffn2_w_up[l], ffn2_w_down[l])
    fmod = jnp.einsum('bd,dm->bm', c_act, final_ada_w) + final_ada_b
    fsh, fsc = jnp.split(fmod, 2, axis=-1)
    return modulate(x, final_norm, fsh, fsc)
```

```cpp
#include <hip/hip_runtime.h>
#include <hip/hip_cooperative_groups.h>
#include <cstdio>
namespace cg = cooperative_groups;
namespace pg8 {
#define PG8_LAS __attribute__((address_space(3)))
typedef unsigned short bf16_t;
typedef short bf16x8 __attribute__((ext_vector_type(8)));
typedef float f32x4 __attribute__((ext_vector_type(4)));
typedef unsigned u32x4 __attribute__((ext_vector_type(4)));
constexpr int BM = 256, BK = 64, HALF = 128, HTB = HALF * BK * 2  , STAGE_BYTES = 8 * HTB, NXCD = 8, WGM = 8;

__host__ __device__ __forceinline__ int lds_byte(int r, int c) { const int st = (r >> 4) * 2 + (c >> 5), rr = r & 15, cc = c & 31, ob = rr * 64 + cc * 2; return st * 1024 + (ob ^ (((ob >> 9) & 1) << 5)); }
__host__ __device__ __forceinline__ void stage_rc(int b, int& R, int& C) { const int st = b / 1024, sb = b % 1024, swz = sb ^ (((sb >> 9) & 1) << 5); R = (st >> 1) * 16 + swz / 64; C = (st & 1) * 32 + (swz % 64) / 2; }
__host__ __device__ __forceinline__ int perm32(int rho) { const int n = rho >> 4, i = rho & 15; return 8 * (i >> 2) + 4 * n + (i & 3); }

struct Unit { int pm, pn; };
struct Gemm { const bf16_t* A; const bf16_t* Bt; int M, N, K; };

struct StaticOrder {
    int nM, nN, nwg, G, c;
    __host__ __device__ void init(int M, int N, int G_, int c_) { nM = M / BM; nN = N / BM; nwg = nM * nN; G = G_; c = c_; }
    __host__ __device__ bool next(int i, Unit& u) const {
        const long L = (long)i * G + c; if (L >= nwg) return false;
        int wgid = (int)L; { const int q = nwg / NXCD, r = nwg % NXCD, xcd = wgid % NXCD, off = wgid / NXCD; wgid = (xcd < r ? xcd * (q + 1) : r * (q + 1) + (xcd - r) * q) + off; }
        const int nig = WGM * nN, gid = wgid / nig, fm = gid * WGM, gsz = (nM - fm) < WGM ? (nM - fm) : WGM;
        u.pm = fm + ((wgid % nig) % gsz); u.pn = (wgid % nig) / gsz; return true;
    }
    __device__ __forceinline__ void a_ready(const Unit&) const {}
    __device__ __forceinline__ void done(const Unit&) const {}
};
__device__ __forceinline__ unsigned cvt_pk_bf16(float lo, float hi) { unsigned r; asm volatile("v_cvt_pk_bf16_f32 %0, %1, %2" : "=v"(r) : "v"(lo), "v"(hi)); return r; }
template <class Epi, class Sched>
__device__ __forceinline__ void gemm_phase(PG8_LAS unsigned char* lds, const Gemm g, const Sched& S, const Epi& E, const int tid) {
    const int wid = __builtin_amdgcn_readfirstlane(tid >> 6), lane = tid & 63, wr = wid >> 2, wc = wid & 3, fr = lane & 15, fq = lane >> 4;
    const int K = g.K, nt = K / BK;
    unsigned voffA[2], voffB[2];
#pragma unroll
    for (int i = 0; i < 2; ++i) { int R, C; stage_rc(tid * 16 + i * 8192, R, C); const int Rb = Epi::PERM ? ((R & ~31) + perm32(R & 31)) : R;
        voffA[i] = (unsigned)(R * K + C) * 2u; voffB[i] = (unsigned)(Rb * K + C) * 2u; }
    const size_t kstep = (size_t)(BK * 2);
    const size_t hstep = (size_t)HALF * K * 2;
    const size_t tstep = 2 * hstep;
    const unsigned ldsw = (unsigned)wid * 1024u;
    const int aoff = lds_byte(wr * 64 + fr, fq * 8), boff = lds_byte(wc * 32 + fr, fq * 8);
#define PG8_SA(b, h) (((b) * 2 + (h)) * HTB)
#define PG8_SB(b, h) ((4 + (b) * 2 + (h)) * HTB)
#define PG8_STAGE(bufoff, gbase, voff) do { _Pragma("unroll") for (int _i = 0; _i < 2; ++_i) \
        __builtin_amdgcn_global_load_lds((const unsigned*)((const char*)(gbase) + (voff)[_i]), (PG8_LAS unsigned*)(lds + (bufoff) + ldsw + _i * 8192), 16, 0, 0); } while (0)
#define PG8_LDA(dst, b, h) do { _Pragma("unroll") for (int m = 0; m < 4; ++m) _Pragma("unroll") for (int k = 0; k < 2; ++k) dst[m][k] = *(const PG8_LAS bf16x8*)(lds + PG8_SA(b, h) + aoff + m * 2048 + k * 1024); } while (0)
#define PG8_LDB(dst, b, h) do { _Pragma("unroll") for (int n = 0; n < 2; ++n) _Pragma("unroll") for (int k = 0; k < 2; ++k) dst[n][k] = *(const PG8_LAS bf16x8*)(lds + PG8_SB(b, h) + boff + n * 2048 + k * 1024); } while (0)
#define PG8_MMA(ai, bj, At, Bt) do { __builtin_amdgcn_s_setprio(1); _Pragma("unroll") for (int m = 0; m < 4; ++m) _Pragma("unroll") for (int n = 0; n < 2; ++n) _Pragma("unroll") for (int k = 0; k < 2; ++k) \
        acc[ai][bj][m][n] = __builtin_amdgcn_mfma_f32_16x16x32_bf16(Bt[n][k], At[m][k], acc[ai][bj][m][n], 0, 0, 0); __builtin_amdgcn_s_setprio(0); } while (0)
#define PG8_WAIT_V(n) asm volatile("s_waitcnt vmcnt(" #n ")" ::: "memory")
#define PG8_WAIT_L(n) asm volatile("s_waitcnt lgkmcnt(" #n ")" ::: "memory")
#define PG8_BAR __builtin_amdgcn_s_barrier()
#define PG8_SCHED __builtin_amdgcn_sched_barrier(0)
    Unit cur, nxt; int ui = 0;
    if (!S.next(0, cur)) return;
    f32x4 acc[2][2][4][2];
#pragma unroll
    for (int a = 0; a < 2; ++a)
#pragma unroll
        for (int b = 0; b < 2; ++b)
#pragma unroll
            for (int m = 0; m < 4; ++m)
#pragma unroll
                for (int n = 0; n < 2; ++n) acc[a][b][m][n] = (f32x4){0.f, 0.f, 0.f, 0.f};
    bf16x8 At[4][2], B0[2][2], B1[2][2];
    const char* cA = (const char*)g.A + (size_t)cur.pm * tstep; const char* cB = (const char*)g.Bt + (size_t)cur.pn * tstep;
    S.a_ready(cur);
    PG8_STAGE(PG8_SB(0, 0), cB, voffB); PG8_STAGE(PG8_SA(0, 0), cA, voffA); PG8_STAGE(PG8_SB(0, 1), cB + hstep, voffB); PG8_STAGE(PG8_SA(0, 1), cA + hstep, voffA);
    if (wr == 1) PG8_BAR;
    PG8_WAIT_V(4); PG8_BAR;
    PG8_STAGE(PG8_SB(1, 0), cB + kstep, voffB); PG8_STAGE(PG8_SA(1, 0), cA + kstep, voffA); PG8_STAGE(PG8_SB(1, 1), cB + hstep + kstep, voffB);
    PG8_WAIT_V(6); PG8_BAR;
    for (;;) {
        const bool has_next = S.next(ui + 1, nxt);
        const char* nA = has_next ? (const char*)g.A + (size_t)nxt.pm * tstep : cA; const char* nB = has_next ? (const char*)g.Bt + (size_t)nxt.pn * tstep : cB;
        for (int t = 0; t < nt; t += 2) {
            const bool last = (t == nt - 2);
            const char* a1 = cA + (size_t)(t + 1) * kstep;
            const char* a2 = last ? nA : cA + (size_t)(t + 2) * kstep; const char* b2 = last ? nB : cB + (size_t)(t + 2) * kstep;
            const char* a3 = a2 + kstep; const char* b3 = b2 + kstep;
            if (last && has_next) S.a_ready(nxt);
            PG8_LDB(B0, 0, 0); PG8_SCHED; PG8_LDA(At, 0, 0); PG8_STAGE(PG8_SA(1, 1), a1 + hstep, voffA);
            PG8_WAIT_L(8); PG8_BAR; PG8_WAIT_L(0); PG8_MMA(0, 0, At, B0); PG8_BAR; PG8_SCHED;
            PG8_LDB(B1, 0, 1); PG8_STAGE(PG8_SB(0, 0), b2, voffB);
            PG8_BAR; PG8_WAIT_L(0); PG8_MMA(0, 1, At, B1); PG8_BAR;
            PG8_LDA(At, 0, 1); PG8_STAGE(PG8_SA(0, 0), a2, voffA);
            PG8_BAR; PG8_WAIT_L(0); PG8_MMA(1, 0, At, B0); PG8_BAR; PG8_SCHED;
            PG8_STAGE(PG8_SB(0, 1), b2 + hstep, voffB);
            PG8_WAIT_V(6); PG8_BAR; PG8_MMA(1, 1, At, B1); PG8_BAR;
            PG8_LDB(B0, 1, 0); PG8_SCHED; PG8_LDA(At, 1, 0); PG8_STAGE(PG8_SA(0, 1), a2 + hstep, voffA);
            PG8_WAIT_L(8); PG8_BAR; PG8_WAIT_L(0); PG8_MMA(0, 0, At, B0); PG8_BAR; PG8_SCHED;
            PG8_LDB(B1, 1, 1); PG8_STAGE(PG8_SB(1, 0), b3, voffB);
            PG8_BAR; PG8_WAIT_L(0); PG8_MMA(0, 1, At, B1); PG8_BAR;
            PG8_LDA(At, 1, 1); PG8_STAGE(PG8_SA(1, 0), a3, voffA);
            PG8_BAR; PG8_WAIT_L(0); PG8_MMA(1, 0, At, B0); PG8_BAR; PG8_SCHED;
            PG8_STAGE(PG8_SB(1, 1), b3 + hstep, voffB);
            PG8_WAIT_V(6); PG8_BAR; PG8_MMA(1, 1, At, B1); PG8_BAR;
        }
        if constexpr (!Epi::AFTER_DRAIN) { E(acc, cur, wr, wc, fr, fq); S.done(cur); }
        if (!has_next) break;
#pragma unroll
        for (int a = 0; a < 2; ++a)
#pragma unroll
            for (int b = 0; b < 2; ++b)
#pragma unroll
                for (int m = 0; m < 4; ++m)
#pragma unroll
                    for (int n = 0; n < 2; ++n) acc[a][b][m][n] = (f32x4){0.f, 0.f, 0.f, 0.f};
        cur = nxt; cA = nA; cB = nB; ++ui;
    }
    PG8_WAIT_V(0);
    if (wr == 0) PG8_BAR;
    PG8_BAR;
    if constexpr (Epi::AFTER_DRAIN) { E.fused(acc, cur, wr, wc, fr, fq, lds, wid, lane); S.done(cur); }
#undef PG8_SA
#undef PG8_SB
#undef PG8_STAGE
#undef PG8_LDA
#undef PG8_LDB
#undef PG8_MMA
#undef PG8_WAIT_V
#undef PG8_WAIT_L
#undef PG8_BAR
#undef PG8_SCHED
}
}

#define LAS __attribute__((address_space(3)))
typedef unsigned short bf16_t;
typedef float f32x4 __attribute__((ext_vector_type(4)));
typedef unsigned u32x4 __attribute__((ext_vector_type(4)));
typedef unsigned u32x2 __attribute__((ext_vector_type(2)));
constexpr int M_ = 32768, D_ = 1024, F_ = 2816, T_ = 8192;
constexpr int NTHREADS = 512;
constexpr int LDS_BYTES = 131072 + 16;
constexpr size_t SZ_TOK512 = (size_t)M_ * 512 * 2;
constexpr size_t WS_BAR = 0;
constexpr size_t WS_MOD = 16384;
constexpr size_t WS_FMOD = WS_MOD + 4 * 9216 * 4;
constexpr size_t WS_WGU1 = WS_FMOD + 4 * 2048 * 4;
constexpr size_t WS_WD1 = WS_WGU1 + (size_t)5632 * 1024 * 2;
constexpr size_t WS_WGU2 = WS_WD1 + (size_t)1024 * 2816 * 2;
constexpr size_t WS_WD2 = WS_WGU2 + (size_t)5632 * 1024 * 2;
constexpr size_t WS_WINC = WS_WD2 + (size_t)1024 * 2816 * 2;
constexpr size_t WS_WINR = WS_WINC + (size_t)1536 * 1024 * 2;
constexpr size_t WS_WLORA = WS_WINR + (size_t)1792 * 1024 * 2;
constexpr size_t WS_WOUT = WS_WLORA + (size_t)2560 * 256 * 2;
constexpr size_t WS_H = WS_WOUT + (size_t)1024 * 1024 * 2;
constexpr size_t WS_YMIX = WS_H + (size_t)M_ * 1024 * 2;
constexpr size_t WS_BIG = WS_YMIX + (size_t)M_ * 1024 * 2;
constexpr size_t WS_EXTRA = WS_BIG + (size_t)M_ * 3328 * 2;
constexpr size_t WS_END = WS_EXTRA + 3 * SZ_TOK512 + (size_t)M_ * 256 * 2;
constexpr size_t WS_HID = WS_BIG;
constexpr size_t WS_PROJC = WS_BIG;
constexpr size_t WS_PROJR = WS_BIG + (size_t)M_ * 1536 * 2;
constexpr size_t WS_OUT5 = WS_BIG;
constexpr size_t WS_YS1 = WS_BIG + 5 * SZ_TOK512;
constexpr size_t WS_R = WS_H;
constexpr size_t WS_K = WS_H + SZ_TOK512;
constexpr size_t WS_V = WS_EXTRA;
constexpr size_t WS_KK = WS_EXTRA + SZ_TOK512;
constexpr size_t WS_AP = WS_EXTRA + 2 * SZ_TOK512;
constexpr size_t WS_YS0 = WS_AP + (size_t)M_ * 256 * 2;
static_assert(WS_END <= 536870912ull, "workspace");

struct Params {
    const float* in[31];
    float* out; unsigned char* ws;
    int ph_lo, ph_hi, coop, pad;
};

__device__ __forceinline__ float sigm(float x) { return __builtin_amdgcn_rcpf(1.0f + __builtin_amdgcn_exp2f(-1.44269504f * x)); }
__device__ __forceinline__ unsigned pk_bf16(float lo, float hi) { return pg8::cvt_pk_bf16(lo, hi); }
__device__ __forceinline__ unsigned pk_f16(float lo, float hi) { typedef _Float16 h2 __attribute__((ext_vector_type(2))); h2 v; v.x = (_Float16)lo; v.y = (_Float16)hi; return __builtin_bit_cast(unsigned, v); }
__device__ __forceinline__ float bf_lo(unsigned w) { return __uint_as_float(w << 16); }
__device__ __forceinline__ float bf_hi(unsigned w) { return __uint_as_float(w & 0xffff0000u); }
__device__ __forceinline__ float h_lo(unsigned w) { typedef _Float16 h2 __attribute__((ext_vector_type(2))); h2 v = __builtin_bit_cast(h2, w); return (float)v.x; }
__device__ __forceinline__ float h_hi(unsigned w) { typedef _Float16 h2 __attribute__((ext_vector_type(2))); h2 v = __builtin_bit_cast(h2, w); return (float)v.y; }
__device__ __forceinline__ void unpack8_bf(const u32x4 w, float (&f)[8]) { f[0] = bf_lo(w.x); f[1] = bf_hi(w.x); f[2] = bf_lo(w.y); f[3] = bf_hi(w.y); f[4] = bf_lo(w.z); f[5] = bf_hi(w.z); f[6] = bf_lo(w.w); f[7] = bf_hi(w.w); }
__device__ __forceinline__ void unpack8_h(const u32x4 w, float (&f)[8]) { f[0] = h_lo(w.x); f[1] = h_hi(w.x); f[2] = h_lo(w.y); f[3] = h_hi(w.y); f[4] = h_lo(w.z); f[5] = h_hi(w.z); f[6] = h_lo(w.w); f[7] = h_hi(w.w); }
__device__ __forceinline__ u32x4 pack8_bf(const float (&f)[8]) { u32x4 w; w.x = pk_bf16(f[0], f[1]); w.y = pk_bf16(f[2], f[3]); w.z = pk_bf16(f[4], f[5]); w.w = pk_bf16(f[6], f[7]); return w; }
__device__ __forceinline__ void load8_bf(const bf16_t* p, float (&f)[8]) { unpack8_bf(*(const u32x4*)p, f); }

namespace pg8 {
struct EpiGen {
    static constexpr bool PERM = true, AFTER_DRAIN = false;
    int mode;
    bf16_t* O; int ldo;
    const float* base; float* out; const float* gate; float gscale;
    const float* w0; const float* a0;
    __device__ __forceinline__ void operator()(const f32x4 (&acc)[2][2][4][2], const Unit& u, int wr, int wc, int fr, int fq) const {
        const int row0 = u.pm * BM + wr * 64 + fr;
        if (mode == 1) {
            const int col0 = u.pn * 128 + wc * 32 + 8 * fq;
#pragma unroll
            for (int ai = 0; ai < 2; ++ai)
#pragma unroll
                for (int m = 0; m < 4; ++m) {
                    const f32x4 g0 = acc[ai][0][m][0], g1 = acc[ai][0][m][1], u0 = acc[ai][1][m][0], u1 = acc[ai][1][m][1];
                    float h[8];
#pragma unroll
                    for (int j = 0; j < 4; ++j) { h[j] = g0[j] * sigm(g0[j]) * u0[j]; h[4 + j] = g1[j] * sigm(g1[j]) * u1[j]; }
                    *(u32x4*)(O + (size_t)(row0 + ai * HALF + m * 16) * ldo + col0) = pack8_bf(h);
                }
        } else if (mode == 0) {
            const int col0 = u.pn * BM + wc * 32 + 8 * fq;
#pragma unroll
            for (int ai = 0; ai < 2; ++ai)
#pragma unroll
                for (int m = 0; m < 4; ++m)
#pragma unroll
                    for (int bj = 0; bj < 2; ++bj) {
                        const f32x4 v0 = acc[ai][bj][m][0], v1 = acc[ai][bj][m][1];
                        u32x4 w; w.x = cvt_pk_bf16(v0[0], v0[1]); w.y = cvt_pk_bf16(v0[2], v0[3]); w.z = cvt_pk_bf16(v1[0], v1[1]); w.w = cvt_pk_bf16(v1[2], v1[3]);
                        *(u32x4*)(O + (size_t)(row0 + ai * HALF + m * 16) * ldo + col0 + bj * HALF) = w;
                    }
        } else if (mode == 2) {
            const int b = u.pm >> 5;
            const int col0 = u.pn * BM + wc * 32 + 8 * fq;
            f32x4 gv[2][2];
#pragma unroll
            for (int bj = 0; bj < 2; ++bj)
#pragma unroll
                for (int n = 0; n < 2; ++n) gv[bj][n] = *(const f32x4*)(gate + (size_t)b * 9216 + col0 + bj * HALF + 4 * n) * gscale;
            f32x4 bs[3][2][2];
#define RES_LOAD(it) do { const size_t off_ = (size_t)(row0 + ((it) >> 2) * HALF + ((it) & 3) * 16) * 1024 + col0; \
                _Pragma("unroll") for (int bj = 0; bj < 2; ++bj) _Pragma("unroll") for (int n = 0; n < 2; ++n) bs[(it) % 3][bj][n] = *(const f32x4*)(base + off_ + bj * HALF + 4 * n); } while (0)
            RES_LOAD(0); RES_LOAD(1);
#pragma unroll
            for (int it = 0; it < 8; ++it) {
                if (it + 2 < 8) RES_LOAD(it + 2);
                const size_t off = (size_t)(row0 + (it >> 2) * HALF + (it & 3) * 16) * 1024 + col0;
#pragma unroll
                for (int bj = 0; bj < 2; ++bj)
#pragma unroll
                    for (int n = 0; n < 2; ++n) *(f32x4*)(out + off + bj * HALF + 4 * n) = bs[it % 3][bj][n] + gv[bj][n] * acc[it >> 2][bj][it & 3][n];
            }
#undef RES_LOAD
        } else {
            const int arr = u.pn >> 1;
            const int colt = (u.pn & 1) * 256 + wc * 32 + 8 * fq;
            bf16_t* Ob = O + (size_t)arr * ((size_t)32768 * 512);
            f32x4 bv[2][2];
#pragma unroll
            for (int bj = 0; bj < 2; ++bj)
#pragma unroll
                for (int n = 0; n < 2; ++n) {
                    const int c = colt + bj * HALF + 4 * n;
                    bv[bj][n] = arr < 2 ? *(const f32x4*)(w0 + arr * 512 + c) : (arr < 4 ? *(const f32x4*)(a0 + (arr - 2) * 512 + c) : (f32x4){0.f, 0.f, 0.f, 0.f});
                }
#pragma unroll
            for (int ai = 0; ai < 2; ++ai)
#pragma unroll
                for (int m = 0; m < 4; ++m)
#pragma unroll
                    for (int bj = 0; bj < 2; ++bj) {
                        f32x4 v0 = acc[ai][bj][m][0] + bv[bj][0], v1 = acc[ai][bj][m][1] + bv[bj][1];
                        u32x4 w;
                        if (arr < 4) {
                            const float sc = arr < 2 ? 0.87503877f : 1.0f;
#pragma unroll
                            for (int j = 0; j < 4; ++j) { v0[j] = sc * sigm(v0[j]); v1[j] = sc * sigm(v1[j]); }
                            w.x = pk_f16(v0[0], v0[1]); w.y = pk_f16(v0[2], v0[3]); w.z = pk_f16(v1[0], v1[1]); w.w = pk_f16(v1[2], v1[3]);
                        } else {
                            w.x = cvt_pk_bf16(v0[0], v0[1]); w.y = cvt_pk_bf16(v0[2], v0[3]); w.z = cvt_pk_bf16(v1[0], v1[1]); w.w = cvt_pk_bf16(v1[2], v1[3]);
                        }
                        *(u32x4*)(Ob + (size_t)(row0 + ai * HALF + m * 16) * 512 + colt + bj * HALF) = w;
                    }
        }
    }
};
}

__device__ __forceinline__ float wave_sum64(float v) {
#pragma unroll
    for (int o = 32; o >= 1; o >>= 1) v += __shfl_xor(v, o);
    return v;
}
__device__ __forceinline__ float sum8(float v) { v += __shfl_xor(v, 1); v += __shfl_xor(v, 2); v += __shfl_xor(v, 4); return v; }

__device__ __forceinline__ void p0_prologue(const Params& p, LAS unsigned char* lds, const int tid) {
    unsigned char* ws = p.ws;
    LAS float* sc = (LAS float*)lds;
    LAS float* red = (LAS float*)(lds + 16384);
    {
        const float* c = p.in[1];
        for (int i = tid; i < 4096; i += NTHREADS) { const float v = c[i]; sc[i] = v * sigm(v); }
    }
    __syncthreads();
    for (int cb = blockIdx.x; cb < 176; cb += gridDim.x) {
        const int cc = tid & 63, dg = tid >> 6, col = cb * 64 + cc;
        const float* W; const float* bias; float* dst; int ld, jc;
        if (col < 9216) { W = p.in[2]; bias = p.in[3]; dst = (float*)(ws + WS_MOD); ld = 9216; jc = col; }
        else { W = p.in[28]; bias = p.in[29]; dst = (float*)(ws + WS_FMOD); ld = 2048; jc = col - 9216; }
        float a0 = 0.f, a1 = 0.f, a2 = 0.f, a3 = 0.f;
        const float* wp = W + (size_t)(dg * 128) * ld + jc;
#pragma unroll 8
        for (int d = 0; d < 128; ++d) {
            const float w = wp[(size_t)d * ld]; const int dd = dg * 128 + d;
            a0 += sc[dd] * w; a1 += sc[1024 + dd] * w; a2 += sc[2048 + dd] * w; a3 += sc[3072 + dd] * w;
        }
        red[(dg * 64 + cc) * 4 + 0] = a0; red[(dg * 64 + cc) * 4 + 1] = a1; red[(dg * 64 + cc) * 4 + 2] = a2; red[(dg * 64 + cc) * 4 + 3] = a3;
        __syncthreads();
        if (tid < 256) {
            const int b = tid >> 6, c2 = tid & 63;
            float s = 0.f;
#pragma unroll
            for (int g = 0; g < 8; ++g) s += red[(g * 64 + c2) * 4 + b];
            const int col2 = cb * 64 + c2; const int jc2 = col2 < 9216 ? col2 : col2 - 9216;
            dst[(size_t)b * ld + jc2] = s + bias[jc2];
        }
        __syncthreads();
    }
    LAS float* tile = (LAS float*)(lds + 32768);
    for (int ti = blockIdx.x; ti < 5312; ti += gridDim.x) {
        int job, r;
        if (ti < 4224) { job = ti / 704; r = ti % 704; } else if (ti < 5056) { job = 6; r = ti - 4224; } else { job = 7; r = ti - 5056; }
        const float* W; int K, N;
        switch (job) {
            case 0: W = p.in[5]; K = 1024; N = 2816; break;
            case 1: W = p.in[6]; K = 1024; N = 2816; break;
            case 2: W = p.in[7]; K = 2816; N = 1024; break;
            case 3: W = p.in[25]; K = 1024; N = 2816; break;
            case 4: W = p.in[26]; K = 1024; N = 2816; break;
            case 5: W = p.in[27]; K = 2816; N = 1024; break;
            case 6: W = p.in[9]; K = 1024; N = 3328; break;
            default: W = p.in[23]; K = 1024; N = 1024; break;
        }
        const int nkt = K / 64, kt = r % nkt, ntile = r / nkt;
        {
            const int c = tid & 63, r0 = tid >> 6;
#pragma unroll
            for (int i = 0; i < 8; ++i) { const int kr = i * 8 + r0; tile[kr * 65 + c] = W[(size_t)(kt * 64 + kr) * N + ntile * 64 + c]; }
        }
        __syncthreads();
        {
            const int nl = tid >> 3, k8 = (tid & 7) * 8, n = ntile * 64 + nl;
            bf16_t* dst; int row;
            switch (job) {
                case 0: dst = (bf16_t*)(ws + WS_WGU1); row = 256 * (n >> 7) + (n & 127); break;
                case 1: dst = (bf16_t*)(ws + WS_WGU1); row = 256 * (n >> 7) + 128 + (n & 127); break;
                case 2: dst = (bf16_t*)(ws + WS_WD1); row = n; break;
                case 3: dst = (bf16_t*)(ws + WS_WGU2); row = 256 * (n >> 7) + (n & 127); break;
                case 4: dst = (bf16_t*)(ws + WS_WGU2); row = 256 * (n >> 7) + 128 + (n & 127); break;
                case 5: dst = (bf16_t*)(ws + WS_WD2); row = n; break;
                case 6: if (n < 1536) { dst = (bf16_t*)(ws + WS_WINC); row = n; } else { dst = (bf16_t*)(ws + WS_WINR); row = n - 1536; } break;
                default: dst = (bf16_t*)(ws + WS_WOUT); row = n; break;
            }
            float f[8];
#pragma unroll
            for (int q = 0; q < 8; ++q) f[q] = tile[(k8 + q) * 65 + nl];
            *(u32x4*)(dst + (size_t)row * K + kt * 64 + k8) = pack8_bf(f);
        }
        __syncthreads();
    }
    {
        bf16_t* WL = (bf16_t*)(ws + WS_WLORA);
        const float* w_up = p.in[14]; const float* a_up = p.in[16]; const float* g_up = p.in[17];
        for (int idx = blockIdx.x * NTHREADS + tid; idx < 2560 * 256; idx += gridDim.x * NTHREADS) {
            const int n = idx % 2560, k = idx / 2560;
            float val = 0.f;
            if (n < 1024) { const int d = n >> 9, c = n & 511; if (k < 64) val = w_up[(size_t)(d * 64 + k) * 512 + c]; }
            else if (n < 2048) { const int n2 = n - 1024, d = n2 >> 9, c = n2 & 511; if (k >= 64 && k < 128) val = a_up[(size_t)(d * 64 + k - 64) * 512 + c]; }
            else { const int c = n - 2048; if (k >= 128) val = g_up[(size_t)(k - 128) * 512 + c]; }
            WL[(size_t)n * 256 + k] = (bf16_t)(pk_bf16(val, val) & 0xffffu);
        }
    }
}

template <bool FINAL>
__device__ __forceinline__ void modulate_phase(const float* X, const float* gvec, const float* shift, const float* scale, int mod_ld, bf16_t* outH, float* outF, const int tid,
                                               const bf16_t* delta = nullptr, const float* dgate = nullptr) {
    const int lane = tid & 63, wid = tid >> 6;
    const int gw = blockIdx.x * 8 + wid, nw = gridDim.x * 8;
    f32x4 g4[4];
#pragma unroll
    for (int i = 0; i < 4; ++i) g4[i] = *(const f32x4*)(gvec + i * 256 + lane * 4);
    f32x4 x4[4], xn[4];
    if (gw < M_) {
#pragma unroll
        for (int i = 0; i < 4; ++i) x4[i] = *(const f32x4*)(X + (size_t)gw * 1024 + i * 256 + lane * 4);
    }
    for (int row = gw; row < M_; row += nw) {
        const int b = row >> 13;
        f32x4 sc4[4], sh4[4], gt[4]; u32x2 dw[4];
#pragma unroll
        for (int i = 0; i < 4; ++i) {
            sc4[i] = *(const f32x4*)(scale + (size_t)b * mod_ld + i * 256 + lane * 4);
            sh4[i] = *(const f32x4*)(shift + (size_t)b * mod_ld + i * 256 + lane * 4);
            if (FINAL) { dw[i] = *(const u32x2*)(delta + (size_t)row * 1024 + i * 256 + lane * 4); gt[i] = *(const f32x4*)(dgate + (size_t)b * 9216 + i * 256 + lane * 4); }
        }
        const int nrow = row + nw;
        if (nrow < M_) {
#pragma unroll
            for (int i = 0; i < 4; ++i) xn[i] = *(const f32x4*)(X + (size_t)nrow * 1024 + i * 256 + lane * 4);
        }
        float ss = 0.f;
#pragma unroll
        for (int i = 0; i < 4; ++i) {
            if (FINAL) x4[i] += (gt[i] * 0.5f) * (f32x4){bf_lo(dw[i].x), bf_hi(dw[i].x), bf_lo(dw[i].y), bf_hi(dw[i].y)};
            ss += x4[i][0] * x4[i][0] + x4[i][1] * x4[i][1] + x4[i][2] * x4[i][2] + x4[i][3] * x4[i][3];
        }
        ss = wave_sum64(ss);
        const float rstd = __builtin_amdgcn_rsqf(ss * (1.0f / 1024.0f) + 1e-6f);
#pragma unroll
        for (int i = 0; i < 4; ++i) {
            const f32x4 y = (x4[i] * rstd) * g4[i] * (sc4[i] + 1.0f) + sh4[i];
            if (FINAL) *(f32x4*)(outF + (size_t)row * 1024 + i * 256 + lane * 4) = y;
            else { u32x2 w; w.x = pk_bf16(y[0], y[1]); w.y = pk_bf16(y[2], y[3]); *(u32x2*)(outH + (size_t)row * 1024 + i * 256 + lane * 4) = w; }
        }
#pragma unroll
        for (int i = 0; i < 4; ++i) x4[i] = xn[i];
    }
}

__device__ __forceinline__ void prep_phase(const Params& p, const int tid) {
    const int lane = tid & 63, wid = tid >> 6;
    const int gw = blockIdx.x * 8 + wid, nw = gridDim.x * 8;
    unsigned char* ws = p.ws;
    const int c0 = lane * 8;
    {
        const bf16_t* PC = (const bf16_t*)(ws + WS_PROJC);
        bf16_t* YM = (bf16_t*)(ws + WS_YMIX);
        float cw0[8], cw1[8], cw2[8], cbv[8];
#pragma unroll
        for (int q = 0; q < 8; ++q) { cw0[q] = p.in[10][c0 + q]; cw1[q] = p.in[10][512 + c0 + q]; cw2[q] = p.in[10][1024 + c0 + q]; cbv[q] = p.in[11][c0 + q]; }
        for (int task = gw; task < M_ / 16; task += nw) {
            const int t0 = task * 16, tl0 = t0 & (T_ - 1);
            float up[8], uc[8], un[8], a[8], b[8];
            if (tl0 == 0) {
#pragma unroll
                for (int q = 0; q < 8; ++q) up[q] = 0.f;
            } else {
                load8_bf(PC + (size_t)(t0 - 1) * 1536 + 512 + c0, a); load8_bf(PC + (size_t)(t0 - 1) * 1536 + 1024 + c0, b);
#pragma unroll
                for (int q = 0; q < 8; ++q) up[q] = a[q] * b[q];
            }
            load8_bf(PC + (size_t)t0 * 1536 + 512 + c0, a); load8_bf(PC + (size_t)t0 * 1536 + 1024 + c0, b);
#pragma unroll
            for (int q = 0; q < 8; ++q) uc[q] = a[q] * b[q];
            for (int i = 0; i < 16; ++i) {
                const int tok = t0 + i;
                if (tl0 + i + 1 < T_) {
                    load8_bf(PC + (size_t)(tok + 1) * 1536 + 512 + c0, a); load8_bf(PC + (size_t)(tok + 1) * 1536 + 1024 + c0, b);
#pragma unroll
                    for (int q = 0; q < 8; ++q) un[q] = a[q] * b[q];
                } else {
#pragma unroll
                    for (int q = 0; q < 8; ++q) un[q] = 0.f;
                }
                float cbr[8], y[8];
                load8_bf(PC + (size_t)tok * 1536 + c0, cbr);
#pragma unroll
                for (int q = 0; q < 8; ++q) y[q] = cbr[q] * (cw0[q] * up[q] + cw1[q] * uc[q] + cw2[q] * un[q] + cbv[q]);
                *(u32x4*)(YM + (size_t)tok * 1024 + c0) = pack8_bf(y);
#pragma unroll
                for (int q = 0; q < 8; ++q) { up[q] = uc[q]; uc[q] = un[q]; }
            }
        }
    }
    {
        const bf16_t* PR = (const bf16_t*)(ws + WS_PROJR);
        bf16_t* Ro = (bf16_t*)(ws + WS_R); bf16_t* Ko = (bf16_t*)(ws + WS_K); bf16_t* Vo = (bf16_t*)(ws + WS_V); bf16_t* KKo = (bf16_t*)(ws + WS_KK); bf16_t* APo = (bf16_t*)(ws + WS_AP);
        const float* mu = p.in[12]; const float* k_k = p.in[18];
        float mur[8], muk[8], muv[8], mus[4], kkw[8];
#pragma unroll
        for (int q = 0; q < 8; ++q) { mur[q] = mu[c0 + q]; muk[q] = mu[512 + c0 + q]; muv[q] = mu[1024 + c0 + q]; kkw[q] = k_k[c0 + q]; }
#pragma unroll
        for (int q = 0; q < 4; ++q) mus[q] = mu[1536 + lane * 4 + q];
        for (int task = gw; task < M_ / 16; task += nw) {
            const int t0 = task * 16, tl0 = t0 & (T_ - 1);
            float pr[8], pk[8], pv[8], ps[4], cr[8], ck[8], cv[8], cs[4], nr[8], nk[8], nv[8], ns[4];
            if (tl0 == 0) {
#pragma unroll
                for (int q = 0; q < 8; ++q) { pr[q] = 0.f; pk[q] = 0.f; pv[q] = 0.f; }
#pragma unroll
                for (int q = 0; q < 4; ++q) ps[q] = 0.f;
            } else {
                const bf16_t* b = PR + (size_t)(t0 - 1) * 1792;
                load8_bf(b + c0, pr); load8_bf(b + 512 + c0, pk); load8_bf(b + 1024 + c0, pv);
                const u32x2 w = *(const u32x2*)(b + 1536 + lane * 4); ps[0] = bf_lo(w.x); ps[1] = bf_hi(w.x); ps[2] = bf_lo(w.y); ps[3] = bf_hi(w.y);
            }
            {
                const bf16_t* b = PR + (size_t)t0 * 1792;
                load8_bf(b + c0, cr); load8_bf(b + 512 + c0, ck); load8_bf(b + 1024 + c0, cv);
                const u32x2 w = *(const u32x2*)(b + 1536 + lane * 4); cs[0] = bf_lo(w.x); cs[1] = bf_hi(w.x); cs[2] = bf_lo(w.y); cs[3] = bf_hi(w.y);
            }
            for (int i = 0; i < 16; ++i) {
                const int tok = t0 + i;
                if (tl0 + i + 1 < T_) {
                    const bf16_t* b = PR + (size_t)(tok + 1) * 1792;
                    load8_bf(b + c0, nr); load8_bf(b + 512 + c0, nk); load8_bf(b + 1024 + c0, nv);
                    const u32x2 w = *(const u32x2*)(b + 1536 + lane * 4); ns[0] = bf_lo(w.x); ns[1] = bf_hi(w.x); ns[2] = bf_lo(w.y); ns[3] = bf_hi(w.y);
                } else {
#pragma unroll
                    for (int q = 0; q < 8; ++q) { nr[q] = 0.f; nk[q] = 0.f; nv[q] = 0.f; }
#pragma unroll
                    for (int q = 0; q < 4; ++q) ns[q] = 0.f;
                }
                float rs[8], ks[8], vs[8], kkv[8], ss = 0.f;
#pragma unroll
                for (int q = 0; q < 8; ++q) {
                    rs[q] = cr[q] + mur[q] * (0.5f * (pr[q] + nr[q]) - cr[q]);
                    ks[q] = ck[q] + muk[q] * (0.5f * (pk[q] + nk[q]) - ck[q]);
                    vs[q] = cv[q] + muv[q] * (0.5f * (pv[q] + nv[q]) - cv[q]);
                    kkv[q] = ks[q] * kkw[q]; ss += kkv[q] * kkv[q];
                }
                ss = sum8(ss);
                const float rn = __builtin_amdgcn_rsqf(ss + 1e-12f);
#pragma unroll
                for (int q = 0; q < 8; ++q) kkv[q] *= rn;
                *(u32x4*)(Ro + (size_t)tok * 512 + c0) = pack8_bf(rs);
                *(u32x4*)(Ko + (size_t)tok * 512 + c0) = pack8_bf(ks);
                *(u32x4*)(Vo + (size_t)tok * 512 + c0) = pack8_bf(vs);
                *(u32x4*)(KKo + (size_t)tok * 512 + c0) = pack8_bf(kkv);
                float sv[4];
#pragma unroll
                for (int q = 0; q < 4; ++q) {
                    const float s = cs[q] + mus[q] * (0.5f * (ps[q] + ns[q]) - cs[q]);
                    const float th = 2.0f * sigm(2.0f * s) - 1.0f, sg = sigm(s);
                    sv[q] = lane < 16 ? th : (lane < 32 ? s : sg);
                }
                { u32x2 w; w.x = pk_bf16(sv[0], sv[1]); w.y = pk_bf16(sv[2], sv[3]); *(u32x2*)(APo + (size_t)tok * 256 + lane * 4) = w; }
#pragma unroll
                for (int q = 0; q < 8; ++q) { pr[q] = cr[q]; pk[q] = ck[q]; pv[q] = cv[q]; cr[q] = nr[q]; ck[q] = nk[q]; cv[q] = nv[q]; }
#pragma unroll
                for (int q = 0; q < 4; ++q) { ps[q] = cs[q]; cs[q] = ns[q]; }
            }
        }
    }
}

typedef float f32x2 __attribute__((ext_vector_type(2)));
template <int CTRL> __device__ __forceinline__ float dpp_add(float x) { return x + __int_as_float(__builtin_amdgcn_update_dpp(0, __float_as_int(x), CTRL, 0xf, 0xf, false)); }
__device__ __forceinline__ float allsum16(float x) { x = dpp_add<0x121>(x); x = dpp_add<0x122>(x); x = dpp_add<0x124>(x); x = dpp_add<0x128>(x); return x; }
#define SCAN_BAR() asm volatile("s_waitcnt lgkmcnt(0)\n\ts_barrier" ::: "memory")
constexpr int SC_STEP = 1024, SC_CH = 64, SC_BUF = SC_STEP * SC_CH, SC_NCH = T_ / SC_CH;
typedef _Float16 h8 __attribute__((ext_vector_type(8)));
struct ScanOps { f32x4 W; u32x4 KKWR, KKAKD; f32x4 VC; };
template <int S> __device__ __forceinline__ void scan_ld(ScanOps& o, const unsigned bp, const unsigned vp) {
    asm volatile("ds_read_b128 %0, %1 offset:%2" : "=v"(o.KKWR) : "v"(bp), "n"(S * SC_STEP + 256));
    asm volatile("ds_read_b128 %0, %1 offset:%2" : "=v"(o.VC) : "v"(vp), "n"(S * SC_STEP));
    asm volatile("ds_read_b128 %0, %1 offset:%2" : "=v"(o.W) : "v"(bp), "n"(S * SC_STEP));
    asm volatile("ds_read_b128 %0, %1 offset:%2" : "=v"(o.KKAKD) : "v"(bp), "n"(S * SC_STEP + 512));
}
template <int N> __device__ __forceinline__ void scan_wait(ScanOps& o) {
    asm volatile("s_waitcnt lgkmcnt(%4)" : "+v"(o.W), "+v"(o.KKWR), "+v"(o.KKAKD), "+v"(o.VC) : "n"(N));
}
__device__ __forceinline__ float scan_step(float (&st)[4], const ScanOps& o) {
    const h8 a = __builtin_bit_cast(h8, o.KKWR), b = __builtin_bit_cast(h8, o.KKAKD);
    const float v = o.VC[0];
    float pa = __builtin_fmaf(st[0], (float)a[0], o.VC[3]); pa = __builtin_fmaf(st[1], (float)a[1], pa); pa = __builtin_fmaf(st[2], (float)a[2], pa);
    float pb = __builtin_fmaf(st[0], (float)a[4], o.VC[1]); pb = __builtin_fmaf(st[1], (float)a[5], pb); pb = __builtin_fmaf(st[2], (float)a[6], pb);
    float sa = __builtin_fmaf(st[3], (float)a[3], pa);
    const float pp = __builtin_fmaf(st[3], (float)a[7], pb);
    const f32x2 m01 = (f32x2){st[0], st[1]} * (f32x2){o.W[0], o.W[1]};
    sa = dpp_add<0x121>(sa);
    const f32x2 m23 = (f32x2){st[2], st[3]} * (f32x2){o.W[2], o.W[3]};
    sa = dpp_add<0x122>(sa);
    const float t0 = __builtin_fmaf((float)b[4], v, m01[0]), t1 = __builtin_fmaf((float)b[5], v, m01[1]);
    sa = dpp_add<0x124>(sa);
    const float t2 = __builtin_fmaf((float)b[6], v, m23[0]), t3 = __builtin_fmaf((float)b[7], v, m23[1]);
    sa = dpp_add<0x128>(sa);
    st[0] = __builtin_fmaf(-(float)b[0], sa, t0); st[1] = __builtin_fmaf(-(float)b[1], sa, t1); st[2] = __builtin_fmaf(-(float)b[2], sa, t2); st[3] = __builtin_fmaf(-(float)b[3], sa, t3);
    return __builtin_fmaf(-sa, o.VC[2], pp);
}
template <int CTRL> __device__ __forceinline__ float dpp_mov(float x) { return __int_as_float(__builtin_amdgcn_update_dpp(0, __float_as_int(x), CTRL, 0xf, 0xf, false)); }
__device__ __forceinline__ float transpose_reduce16(float (&p)[16], const int j) {
#define TR_A(lo, hi) asm volatile("v_add_f32_dpp %0, %0, %0 row_ror:8 row_mask:0xf bank_mask:0xc\n\tv_add_f32_dpp %0, %1, %1 row_ror:8 row_mask:0xf bank_mask:0x3" : "+v"(hi) : "v"(lo))
#define TR_AN(lo, hi) asm volatile("s_nop 1\n\tv_add_f32_dpp %0, %0, %0 row_ror:8 row_mask:0xf bank_mask:0xc\n\tv_add_f32_dpp %0, %1, %1 row_ror:8 row_mask:0xf bank_mask:0x3" : "+v"(hi) : "v"(lo))
    TR_A(p[0], p[8]); TR_A(p[1], p[9]); TR_A(p[2], p[10]); TR_A(p[3], p[11]); TR_A(p[4], p[12]); TR_AN(p[5], p[13]); TR_AN(p[6], p[14]); TR_AN(p[7], p[15]);
#undef TR_A
#undef TR_AN
#define TR_B(lo, hi) asm volatile("v_add_f32_dpp %0, %0, %0 row_ror:4 row_mask:0xf bank_mask:0xa\n\tv_add_f32_dpp %0, %1, %1 row_ror:12 row_mask:0xf bank_mask:0x5" : "+v"(hi) : "v"(lo))
    TR_B(p[8], p[12]); TR_B(p[9], p[13]); TR_B(p[10], p[14]); TR_B(p[11], p[15]);
#undef TR_B
    const bool b1 = (j & 2) != 0, b0 = (j & 1) != 0;
    float q0, q1;
    { const float keep = b1 ? p[14] : p[12], send = b1 ? p[12] : p[14]; q0 = keep + dpp_mov<0x4E>(send); }
    { const float keep = b1 ? p[15] : p[13], send = b1 ? p[13] : p[15]; q1 = keep + dpp_mov<0x4E>(send); }
    const float keep = b0 ? q1 : q0, send = b0 ? q0 : q1;
    return keep + dpp_mov<0xB1>(send);
}
template <int S> __device__ __forceinline__ void scan_pair(float (&st)[4], float (&pacc)[16], ScanOps& A, ScanOps& B, const unsigned bp, const unsigned vp, const int j,
                                                          bf16_t* const yrow, const long ystep) {
    scan_ld<S + 1>(B, bp, vp);
    scan_wait<4>(A);
    pacc[S & 15] = scan_step(st, A);
    if constexpr (S + 2 < SC_CH) { scan_ld<S + 2>(A, bp, vp); scan_wait<4>(B); } else { scan_wait<0>(B); }
    pacc[(S + 1) & 15] = scan_step(st, B);
    if constexpr (((S + 2) & 15) == 0) {
        const float y = transpose_reduce16(pacc, j);
        yrow[(long)((S + 2) / 16 - 1) * 16 * ystep] = (bf16_t)(pk_bf16(y, y) & 0xffffu);
    }
    if constexpr (S + 2 < SC_CH) scan_pair<S + 2>(st, pacc, A, B, bp, vp, j, yrow, ystep);
}

__device__ __forceinline__ void scan_phase(const Params& p, LAS unsigned char* lds, const int tid) {
    const int lane = tid & 63, wid = __builtin_amdgcn_readfirstlane(tid >> 6);
    unsigned char* ws = p.ws;
    const bf16_t* Rg = (const bf16_t*)(ws + WS_R); const bf16_t* Kg = (const bf16_t*)(ws + WS_K); const bf16_t* Vg = (const bf16_t*)(ws + WS_V); const bf16_t* KKg = (const bf16_t*)(ws + WS_KK);
    for (int unit = blockIdx.x; unit < 256; unit += gridDim.x) {
        const int xcd = unit & 7, jj = unit >> 3, seq = xcd * 8 + (jj >> 2), rg = jj & 3;
        const int dir = seq >> 5, b = (seq >> 3) & 3, h = seq & 7;
        const size_t tokbase = (size_t)b * T_; const int ch0 = h * 64;
        const bf16_t* DWg = (const bf16_t*)(ws + WS_OUT5 + (size_t)dir * SZ_TOK512);
        const bf16_t* AAg = (const bf16_t*)(ws + WS_OUT5 + (size_t)(2 + dir) * SZ_TOK512);
        bf16_t* YSg = (bf16_t*)(ws + (dir ? WS_YS1 : WS_YS0));
        if (wid >= 4) {
            const int pt = tid - 256, sl = pt >> 4, kq = pt & 15;
            const f32x4 ka4v = *(const f32x4*)(p.in[19] + ch0 + 4 * kq);
            u32x2 rr[4], kr[4], kkr[4], ar[4], dr[4]; unsigned short vr[4];
#define SC_LOAD(c) do { _Pragma("unroll") for (int e = 0; e < 4; ++e) { const int s = (c) * SC_CH + sl + 16 * e; const int t = dir ? (T_ - 1 - s) : s; \
                const size_t o = (tokbase + t) * 512 + ch0 + 4 * kq; \
                rr[e] = *(const u32x2*)(Rg + o); kr[e] = *(const u32x2*)(Kg + o); kkr[e] = *(const u32x2*)(KKg + o); ar[e] = *(const u32x2*)(AAg + o); dr[e] = *(const u32x2*)(DWg + o); \
                vr[e] = Vg[(tokbase + t) * 512 + ch0 + rg * 16 + kq]; } } while (0)
#define SC_CONV(bufi) do { _Pragma("unroll") for (int e = 0; e < 4; ++e) { LAS unsigned char* bp = lds + (bufi) * SC_BUF + (sl + 16 * e) * SC_STEP; \
                const f32x4 r4 = {bf_lo(rr[e].x), bf_hi(rr[e].x), bf_lo(rr[e].y), bf_hi(rr[e].y)}; \
                const f32x4 k4 = {bf_lo(kr[e].x), bf_hi(kr[e].x), bf_lo(kr[e].y), bf_hi(kr[e].y)}; \
                const f32x4 q4 = {bf_lo(kkr[e].x), bf_hi(kkr[e].x), bf_lo(kkr[e].y), bf_hi(kkr[e].y)}; \
                const f32x4 a4 = {h_lo(ar[e].x), h_hi(ar[e].x), h_lo(ar[e].y), h_hi(ar[e].y)}; \
                f32x4 w4; w4[0] = __builtin_amdgcn_exp2f(-h_lo(dr[e].x)); w4[1] = __builtin_amdgcn_exp2f(-h_hi(dr[e].x)); w4[2] = __builtin_amdgcn_exp2f(-h_lo(dr[e].y)); w4[3] = __builtin_amdgcn_exp2f(-h_hi(dr[e].y)); \
                const f32x4 kka4 = q4 * a4, kd4 = k4 * ((a4 - 1.0f) * ka4v + 1.0f), wr4 = w4 * r4; \
                const f32x4 c1v = kka4 * r4, c2v = kd4 * r4; \
                float c1 = (c1v[0] + c1v[1]) + (c1v[2] + c1v[3]), c2 = (c2v[0] + c2v[1]) + (c2v[2] + c2v[3]); \
                c1 = allsum16(c1); c2 = allsum16(c2); \
                const float vv = __uint_as_float((unsigned)vr[e] << 16); \
                u32x4 kkwr, kkakd; kkwr.x = pk_f16(q4[0], q4[1]); kkwr.y = pk_f16(q4[2], q4[3]); kkwr.z = pk_f16(wr4[0], wr4[1]); kkwr.w = pk_f16(wr4[2], wr4[3]); \
                kkakd.x = pk_f16(kka4[0], kka4[1]); kkakd.y = pk_f16(kka4[2], kka4[3]); kkakd.z = pk_f16(kd4[0], kd4[1]); kkakd.w = pk_f16(kd4[2], kd4[3]); \
                *(LAS f32x4*)(bp + 16 * kq) = w4; *(LAS u32x4*)(bp + 256 + 16 * kq) = kkwr; *(LAS u32x4*)(bp + 512 + 16 * kq) = kkakd; \
                *(LAS f32x4*)(bp + 768 + 16 * kq) = (f32x4){vv, vv * c2 * 0.0625f, c1 * 0.0625f, 0.f}; } } while (0)
            SC_LOAD(0); SC_CONV(0); SC_LOAD(1);
            SCAN_BAR();
            for (int c = 0; c < SC_NCH; ++c) {
                if (c + 1 < SC_NCH) { SC_CONV((c + 1) & 1); }
                if (c + 2 < SC_NCH) { SC_LOAD(c + 2); }
                SCAN_BAR();
            }
#undef SC_LOAD
#undef SC_CONV
        } else {
            const int j = lane & 15, rr_ = lane >> 4, row = rg * 16 + wid * 4 + rr_;
            float st[4] = {0.f, 0.f, 0.f, 0.f};
            float pacc[16];
            const unsigned lbase = (unsigned)(size_t)lds;
            const long ystep = dir ? -512 : 512;
            SCAN_BAR();
            for (int c = 0; c < SC_NCH; ++c) {
                const unsigned cb = lbase + (c & 1) * SC_BUF;
                const unsigned bp = cb + 16 * j, vp = cb + 768 + 16 * (wid * 4 + rr_);
                const int sg = c * SC_CH + j; const int t = dir ? (T_ - 1 - sg) : sg;
                bf16_t* const yrow = YSg + (tokbase + t) * 512 + ch0 + row;
                ScanOps A, B;
                scan_ld<0>(A, bp, vp);
                scan_pair<0>(st, pacc, A, B, bp, vp, j, yrow, ystep);
                asm volatile("" : "+v"(st[0]), "+v"(st[1]), "+v"(st[2]), "+v"(st[3]));
                SCAN_BAR();
            }
        }
    }
}

__device__ __forceinline__ void combine_phase(const Params& p, const int tid) {
    const int lane = tid & 63, wid = tid >> 6;
    const int gw = blockIdx.x * 8 + wid, nw = gridDim.x * 8;
    unsigned char* ws = p.ws;
    const int c0 = lane * 8;
    const bf16_t* Y0 = (const bf16_t*)(ws + WS_YS0); const bf16_t* Y1 = (const bf16_t*)(ws + WS_YS1);
    const bf16_t* Rg = (const bf16_t*)(ws + WS_R); const bf16_t* Kg = (const bf16_t*)(ws + WS_K); const bf16_t* Vg = (const bf16_t*)(ws + WS_V);
    const bf16_t* A0 = (const bf16_t*)(ws + WS_OUT5 + 2 * SZ_TOK512); const bf16_t* A1 = (const bf16_t*)(ws + WS_OUT5 + 3 * SZ_TOK512); const bf16_t* Gg = (const bf16_t*)(ws + WS_OUT5 + 4 * SZ_TOK512);
    bf16_t* YM = (bf16_t*)(ws + WS_YMIX);
    float gnw[8], gnb[8], rk[8], ka[8];
#pragma unroll
    for (int q = 0; q < 8; ++q) { gnw[q] = p.in[21][c0 + q]; gnb[q] = p.in[22][c0 + q]; rk[q] = p.in[20][c0 + q]; ka[q] = p.in[19][c0 + q]; }
    u32x4 cur[8], nxt[8];
#define CMB_LOAD(dst, tk) do { const size_t o_ = (size_t)(tk) * 512 + c0; dst[0] = *(const u32x4*)(Y0 + o_); dst[1] = *(const u32x4*)(Y1 + o_); dst[2] = *(const u32x4*)(Rg + o_); dst[3] = *(const u32x4*)(Kg + o_); \
        dst[4] = *(const u32x4*)(Vg + o_); dst[5] = *(const u32x4*)(Gg + o_); dst[6] = *(const u32x4*)(A0 + o_); dst[7] = *(const u32x4*)(A1 + o_); } while (0)
    if (gw < M_) CMB_LOAD(cur, gw);
    for (int tok = gw; tok < M_; tok += nw) {
        if (tok + nw < M_) CMB_LOAD(nxt, tok + nw);
        float y0[8], y1[8], r[8], k[8], v[8], a0[8], a1[8], g[8];
        unpack8_bf(cur[0], y0); unpack8_bf(cur[1], y1); unpack8_bf(cur[2], r); unpack8_bf(cur[3], k); unpack8_bf(cur[4], v); unpack8_bf(cur[5], g);
        unpack8_h(cur[6], a0); unpack8_h(cur[7], a1);
        float y[8], s = 0.f, bs = 0.f;
#pragma unroll
        for (int q = 0; q < 8; ++q) { y[q] = y0[q] + y1[q]; s += y[q]; bs += r[q] * k[q] * rk[q] * (2.0f + (a0[q] + a1[q] - 2.0f) * ka[q]); }
        s = sum8(s); bs = sum8(bs);
        const float mean = s * (1.0f / 64.0f);
        float qv = 0.f;
#pragma unroll
        for (int q = 0; q < 8; ++q) { y[q] -= mean; qv += y[q] * y[q]; }
        qv = sum8(qv);
        const float rstd = __builtin_amdgcn_rsqf(qv * (1.0f / 64.0f) + 64e-5f);
        float o8[8];
#pragma unroll
        for (int q = 0; q < 8; ++q) o8[q] = ((y[q] * rstd) * gnw[q] + gnb[q] + bs * v[q]) * g[q];
        *(u32x4*)(YM + (size_t)tok * 1024 + 512 + c0) = pack8_bf(o8);
#pragma unroll
        for (int q = 0; q < 8; ++q) cur[q] = nxt[q];
    }
#undef CMB_LOAD
}

#define XB_TMO      128
#define XB_XCNT(j)  (256  + 64 * (j))
#define XB_XSUB(j)  (1280 + 64 * (j))
#define XB_XGEN(j)  (2304 + 64 * (j))
#define XB_TOP      3328
#define XB_TOPGEN   3392
#define XCD_BAR_WORDS 3456
#define XB_SPIN_CAP (1u << 18)

__device__ __forceinline__ unsigned xb_ld(unsigned* p)              { return __hip_atomic_load(p, __ATOMIC_RELAXED, __HIP_MEMORY_SCOPE_AGENT); }
__device__ __forceinline__ unsigned xb_add(unsigned* p, unsigned v) { return __hip_atomic_fetch_add(p, v, __ATOMIC_RELAXED, __HIP_MEMORY_SCOPE_AGENT); }
__device__ __forceinline__ unsigned xb_xcc_id() { return (unsigned)__builtin_amdgcn_s_getreg((3 << 11) | 20) & 0xFu; }
#define XB_SPIN(cond, bar) do { unsigned _sp = 0; while (cond) { __builtin_amdgcn_s_sleep(1); \
    if ((++_sp & 255u) == 0u) { if (xb_ld(&(bar)[XB_TMO])) break; if (_sp > XB_SPIN_CAP) { atomicAdd(&(bar)[XB_TMO], 1u); break; } } } } while (0)

struct XcdBarrier {
    unsigned* bar; unsigned x;
    volatile LAS unsigned* st;
};

__device__ __forceinline__ XcdBarrier xcd_barrier_post(unsigned* bar, volatile LAS unsigned* st) {
    XcdBarrier b; b.bar = bar; b.x = xb_xcc_id(); b.st = st;
    if (threadIdx.x == 0) (void)xb_add(&bar[XB_XCNT(b.x)], 1u);
    return b;
}
__device__ __forceinline__ void xcd_barrier_complete(unsigned* bar, unsigned x, unsigned& nloc, unsigned& nx) {
    const unsigned G = gridDim.x * gridDim.y * gridDim.z;
    unsigned sum, cnt, mine, sp = 0u;
    for (;;) {
        sum = 0u; cnt = 0u; mine = 0u;
#pragma unroll
        for (unsigned j = 0; j < 16; ++j) { const unsigned c = xb_ld(&bar[XB_XCNT(j)]); sum += c; cnt += (c > 0u) ? 1u : 0u; mine = (j == x) ? c : mine; }
        if (sum == G) break;
        __builtin_amdgcn_s_sleep(1);
        if ((++sp & 255u) == 0u) { if (xb_ld(&bar[XB_TMO])) break; if (sp > XB_SPIN_CAP) { atomicAdd(&bar[XB_TMO], 1u); break; } }
    }
    nloc = mine > 0u ? mine : 1u; nx = cnt > 0u ? cnt : 1u;
}

__device__ __forceinline__ void xcd_barrier(const XcdBarrier& b) {
    asm volatile("s_waitcnt vmcnt(0)" ::: "memory");
    __syncthreads();
    if (threadIdx.x == 0) {
        unsigned* bar = b.bar;
        __builtin_amdgcn_s_waitcnt(0);
        unsigned nloc = b.st[0], nx = b.st[1];
        if (nloc == 0u) { xcd_barrier_complete(bar, b.x, nloc, nx); b.st[0] = nloc; b.st[1] = nx; }
        const unsigned old = xb_add(&bar[XB_XSUB(b.x)], 1u);
        const unsigned gen = old / nloc;
        if (old + 1u == (gen + 1u) * nloc) {
            __builtin_amdgcn_fence(__ATOMIC_RELEASE, "agent");
            asm volatile("s_waitcnt vmcnt(0)" ::: "memory");
            const unsigned og = xb_add(&bar[XB_TOP], 1u);
            const unsigned tg = og / nx;
            if (og + 1u == (tg + 1u) * nx) xb_add(&bar[XB_TOPGEN], 1u);
            else XB_SPIN(xb_ld(&bar[XB_TOPGEN]) == tg, bar);
            __builtin_amdgcn_fence(__ATOMIC_ACQUIRE, "agent");
            xb_add(&bar[XB_XGEN(b.x)], 1u);
            asm volatile("s_waitcnt vmcnt(0)" ::: "memory");
        } else {
            XB_SPIN(xb_ld(&bar[XB_XGEN(b.x)]) == gen, bar);
            __builtin_amdgcn_fence(__ATOMIC_ACQUIRE, "agent");
            asm volatile("s_waitcnt vmcnt(0)" ::: "memory");
        }
    }
    __syncthreads();
}

#ifndef PROBE_MASK
#define PROBE_MASK 0
#endif
__global__ void __launch_bounds__(NTHREADS, 2) fwd_kernel(Params p) {
    extern __shared__ __attribute__((aligned(16))) unsigned char lds_raw[];
    LAS unsigned char* lds = (LAS unsigned char*)lds_raw;
    unsigned char* ws = p.ws;
    float* mod = (float*)(ws + WS_MOD); float* fmod = (float*)(ws + WS_FMOD);
    bf16_t* H = (bf16_t*)(ws + WS_H);
    if (threadIdx.x < 4) ((LAS unsigned*)(lds + 131072))[threadIdx.x] = 0u;
    __syncthreads();
    XcdBarrier bar; bar.bar = (unsigned*)(ws + WS_BAR); bar.x = 0; bar.st = (volatile LAS unsigned*)(lds + 131072);
    if (p.coop) bar = xcd_barrier_post((unsigned*)(ws + WS_BAR), (volatile LAS unsigned*)(lds + 131072));
    for (int ph = p.ph_lo; ph < p.ph_hi; ++ph) {
        for (int rep = 0; rep < (((PROBE_MASK >> ph) & 1) ? 2 : 1); ++rep) {
        if (rep) __syncthreads();
        int tid = threadIdx.x; asm volatile("" : "+v"(tid));
        switch (ph) {
            case 0: p0_prologue(p, lds, tid); break;
            case 1: modulate_phase<false>(p.in[0], p.in[4], mod + 0, mod + 1024, 9216, H, nullptr, tid); break;
            case 4: modulate_phase<false>(p.out, p.in[8], mod + 3072, mod + 4096, 9216, H, nullptr, tid); break;
            case 12: modulate_phase<false>(p.out, p.in[24], mod + 6144, mod + 7168, 9216, H, nullptr, tid); break;
            case 15: modulate_phase<true>(p.out, p.in[30], fmod + 0, fmod + 1024, 2048, nullptr, p.out, tid, H, mod + 8192); break;
            case 7: prep_phase(p, tid); break;
            case 9: scan_phase(p, lds, tid); break;
            case 10: combine_phase(p, tid); break;
            default: {
                pg8::Gemm g; pg8::EpiGen E;
                E.mode = 0; E.O = nullptr; E.ldo = 0; E.base = nullptr; E.out = nullptr; E.gate = nullptr; E.gscale = 1.f; E.w0 = p.in[13]; E.a0 = p.in[15];
                g.M = M_;
                switch (ph) {
                    case 2: g.A = H; g.Bt = (const bf16_t*)(ws + WS_WGU1); g.N = 5632; g.K = 1024; E.mode = 1; E.O = (bf16_t*)(ws + WS_HID); E.ldo = 2816; break;
                    case 3: g.A = (const bf16_t*)(ws + WS_HID); g.Bt = (const bf16_t*)(ws + WS_WD1); g.N = 1024; g.K = 2816; E.mode = 2; E.base = p.in[0]; E.out = p.out; E.gate = mod + 2048; E.gscale = 0.5f; break;
                    case 5: g.A = H; g.Bt = (const bf16_t*)(ws + WS_WINC); g.N = 1536; g.K = 1024; E.mode = 0; E.O = (bf16_t*)(ws + WS_PROJC); E.ldo = 1536; break;
                    case 6: g.A = H; g.Bt = (const bf16_t*)(ws + WS_WINR); g.N = 1792; g.K = 1024; E.mode = 0; E.O = (bf16_t*)(ws + WS_PROJR); E.ldo = 1792; break;
                    case 8: g.A = (const bf16_t*)(ws + WS_AP); g.Bt = (const bf16_t*)(ws + WS_WLORA); g.N = 2560; g.K = 256; E.mode = 3; E.O = (bf16_t*)(ws + WS_OUT5); E.ldo = 512; break;
                    case 11: g.A = (const bf16_t*)(ws + WS_YMIX); g.Bt = (const bf16_t*)(ws + WS_WOUT); g.N = 1024; g.K = 1024; E.mode = 2; E.base = p.out; E.out = p.out; E.gate = mod + 5120; E.gscale = 1.0f; break;
                    case 13: g.A = H; g.Bt = (const bf16_t*)(ws + WS_WGU2); g.N = 5632; g.K = 1024; E.mode = 1; E.O = (bf16_t*)(ws + WS_HID); E.ldo = 2816; break;
                    default: g.A = (const bf16_t*)(ws + WS_HID); g.Bt = (const bf16_t*)(ws + WS_WD2); g.N = 1024; g.K = 2816; E.mode = 0; E.O = H; E.ldo = 1024; break;
                }
                pg8::StaticOrder S; S.init(g.M, g.N, (int)gridDim.x, (int)blockIdx.x);
                pg8::gemm_phase<pg8::EpiGen, pg8::StaticOrder>(lds, g, S, E, tid);
            } break;
        }
        }
        if (ph + 1 < p.ph_hi) {
            if (ph == 5) __syncthreads();
            else if (p.pad != 0) cg::this_grid().sync();
            else xcd_barrier(bar);
        }
    }
}

constexpr int N_PHASES = 16;
#ifndef ONE_LAUNCH
#define ONE_LAUNCH 1
#endif
extern "C" void kernel_launch(void* const* d_in, const int* in_sizes, int n_in, void* d_out, int out_size, void* d_ws, size_t ws_size, hipStream_t stream) {
    static int grid = 0;
    if (grid == 0) {
        int dev = 0, cus = 0, per_cu = 0;
        hipGetDevice(&dev);
        hipDeviceGetAttribute(&cus, hipDeviceAttributeMultiprocessorCount, dev);
        hipFuncSetAttribute((const void*)fwd_kernel, hipFuncAttributeMaxDynamicSharedMemorySize, LDS_BYTES);
        hipOccupancyMaxActiveBlocksPerMultiprocessor(&per_cu, (const void*)fwd_kernel, NTHREADS, LDS_BYTES);
        if (per_cu < 1) per_cu = 1;
        grid = cus * 1;
        if (grid <= 0) grid = 256;
        if (ws_size < WS_END) fprintf(stderr, "kernel_launch: workspace too small: %zu < %zu\n", ws_size, (size_t)WS_END);
        if (n_in != 31) fprintf(stderr, "kernel_launch: expected 31 inputs, got %d\n", n_in);
        (void)hipGetLastError();
    }
    Params p{};
    for (int i = 0; i < 31; ++i) p.in[i] = (const float*)d_in[i];
    p.out = (float*)d_out; p.ws = (unsigned char*)d_ws; p.pad = 0;
#if ONE_LAUNCH
    (void)hipMemsetAsync((char*)d_ws + WS_BAR, 0, 16384, stream);
    p.ph_lo = 0; p.ph_hi = N_PHASES; p.coop = 1;
    void* args[] = {&p};
    hipError_t e = hipLaunchCooperativeKernel((const void*)fwd_kernel, dim3(grid), dim3(NTHREADS), args, LDS_BYTES, stream);
    if (e != hipSuccess) fprintf(stderr, "cooperative launch failed: %s (grid %d)\n", hipGetErrorString(e), grid);
#else
    p.coop = 0;
    for (int ph = 0; ph < N_PHASES; ++ph) {
        p.ph_lo = ph; p.ph_hi = ph + 1;
        hipLaunchKernelGGL(fwd_kernel, dim3(grid), dim3(NTHREADS), LDS_BYTES, stream, p);
    }
#endif
}
```

```cpp
#include <hip/hip_runtime.h>
#include <hip/hip_cooperative_groups.h>
#include <cstdio>
namespace cg = cooperative_groups;
namespace pg8 {
#define PG8_LAS __attribute__((address_space(3)))
typedef unsigned short bf16_t;
typedef short bf16x8 __attribute__((ext_vector_type(8)));
typedef float f32x4 __attribute__((ext_vector_type(4)));
typedef unsigned u32x4 __attribute__((ext_vector_type(4)));
constexpr int BM = 256, BK = 64, HALF = 128, HTB = HALF * BK * 2  , STAGE_BYTES = 8 * HTB, NXCD = 8, WGM = 8;

__host__ __device__ __forceinline__ int lds_byte(int r, int c) { const int st = (r >> 4) * 2 + (c >> 5), rr = r & 15, cc = c & 31, ob = rr * 64 + cc * 2; return st * 1024 + (ob ^ (((ob >> 9) & 1) << 5)); }
__host__ __device__ __forceinline__ void stage_rc(int b, int& R, int& C) { const int st = b / 1024, sb = b % 1024, swz = sb ^ (((sb >> 9) & 1) << 5); R = (st >> 1) * 16 + swz / 64; C = (st & 1) * 32 + (swz % 64) / 2; }
__host__ __device__ __forceinline__ int perm32(int rho) { const int n = rho >> 4, i = rho & 15; return 8 * (i >> 2) + 4 * n + (i & 3); }

struct Unit { int pm, pn; };
struct Gemm { const bf16_t* A; const bf16_t* Bt; int M, N, K; };

struct StaticOrder {
    int nM, nN, nwg, G, c;
    __host__ __device__ void init(int M, int N, int G_, int c_) { nM = M / BM; nN = N / BM; nwg = nM * nN; G = G_; c = c_; }
    __host__ __device__ bool next(int i, Unit& u) const {
        const long L = (long)i * G + c; if (L >= nwg) return false;
        int wgid = (int)L; { const int q = nwg / NXCD, r = nwg % NXCD, xcd = wgid % NXCD, off = wgid / NXCD; wgid = (xcd < r ? xcd * (q + 1) : r * (q + 1) + (xcd - r) * q) + off; }
        const int nig = WGM * nN, gid = wgid / nig, fm = gid * WGM, gsz = (nM - fm) < WGM ? (nM - fm) : WGM;
        u.pm = fm + ((wgid % nig) % gsz); u.pn = (wgid % nig) / gsz; return true;
    }
    __device__ __forceinline__ void a_ready(const Unit&) const {}
    __device__ __forceinline__ void done(const Unit&) const {}
};
__device__ __forceinline__ unsigned cvt_pk_bf16(float lo, float hi) { unsigned r; asm volatile("v_cvt_pk_bf16_f32 %0, %1, %2" : "=v"(r) : "v"(lo), "v"(hi)); return r; }
template <class Epi, class Sched>
__device__ __forceinline__ void gemm_phase(PG8_LAS unsigned char* lds, const Gemm g, const Sched& S, const Epi& E, const int tid) {
    const int wid = __builtin_amdgcn_readfirstlane(tid >> 6), lane = tid & 63, wr = wid >> 2, wc = wid & 3, fr = lane & 15, fq = lane >> 4;
    const int K = g.K, nt = K / BK;
    unsigned voffA[2], voffB[2];
#pragma unroll
    for (int i = 0; i < 2; ++i) { int R, C; stage_rc(tid * 16 + i * 8192, R, C); const int Rb = Epi::PERM ? ((R & ~31) + perm32(R & 31)) : R;
        voffA[i] = (unsigned)(R * K + C) * 2u; voffB[i] = (unsigned)(Rb * K + C) * 2u; }
    const size_t kstep = (size_t)(BK * 2);
    const size_t hstep = (size_t)HALF * K * 2;
    const size_t tstep = 2 * hstep;
    const unsigned ldsw = (unsigned)wid * 1024u;
    const int aoff = lds_byte(wr * 64 + fr, fq * 8), boff = lds_byte(wc * 32 + fr, fq * 8);
#define PG8_SA(b, h) (((b) * 2 + (h)) * HTB)
#define PG8_SB(b, h) ((4 + (b) * 2 + (h)) * HTB)
#define PG8_STAGE(bufoff, gbase, voff) do { _Pragma("unroll") for (int _i = 0; _i < 2; ++_i) \
        __builtin_amdgcn_global_load_lds((const unsigned*)((const char*)(gbase) + (voff)[_i]), (PG8_LAS unsigned*)(lds + (bufoff) + ldsw + _i * 8192), 16, 0, 0); } while (0)
#define PG8_LDA(dst, b, h) do { _Pragma("unroll") for (int m = 0; m < 4; ++m) _Pragma("unroll") for (int k = 0; k < 2; ++k) dst[m][k] = *(const PG8_LAS bf16x8*)(lds + PG8_SA(b, h) + aoff + m * 2048 + k * 1024); } while (0)
#define PG8_LDB(dst, b, h) do { _Pragma("unroll") for (int n = 0; n < 2; ++n) _Pragma("unroll") for (int k = 0; k < 2; ++k) dst[n][k] = *(const PG8_LAS bf16x8*)(lds + PG8_SB(b, h) + boff + n * 2048 + k * 1024); } while (0)
#define PG8_MMA(ai, bj, At, Bt) do { __builtin_amdgcn_s_setprio(1); _Pragma("unroll") for (int m = 0; m < 4; ++m) _Pragma("unroll") for (int n = 0; n < 2; ++n) _Pragma("unroll") for (int k = 0; k < 2; ++k) \
        acc[ai][bj][m][n] = __builtin_amdgcn_mfma_f32_16x16x32_bf16(Bt[n][k], At[m][k], acc[ai][bj][m][n], 0, 0, 0); __builtin_amdgcn_s_setprio(0); } while (0)
#define PG8_WAIT_V(n) asm volatile("s_waitcnt vmcnt(" #n ")" ::: "memory")
#define PG8_WAIT_L(n) asm volatile("s_waitcnt lgkmcnt(" #n ")" ::: "memory")
#define PG8_BAR __builtin_amdgcn_s_barrier()
#define PG8_SCHED __builtin_amdgcn_sched_barrier(0)
    Unit cur, nxt; int ui = 0;
    if (!S.next(0, cur)) return;
    f32x4 acc[2][2][4][2];
#pragma unroll
    for (int a = 0; a < 2; ++a)
#pragma unroll
        for (int b = 0; b < 2; ++b)
#pragma unroll
            for (int m = 0; m < 4; ++m)
#pragma unroll
                for (int n = 0; n < 2; ++n) acc[a][b][m][n] = (f32x4){0.f, 0.f, 0.f, 0.f};
    bf16x8 At[4][2], B0[2][2], B1[2][2];
    const char* cA = (const char*)g.A + (size_t)cur.pm * tstep; const char* cB = (const char*)g.Bt + (size_t)cur.pn * tstep;
    S.a_ready(cur);
    PG8_STAGE(PG8_SB(0, 0), cB, voffB); PG8_STAGE(PG8_SA(0, 0), cA, voffA); PG8_STAGE(PG8_SB(0, 1), cB + hstep, voffB); PG8_STAGE(PG8_SA(0, 1), cA + hstep, voffA);
    if (wr == 1) PG8_BAR;
    PG8_WAIT_V(4); PG8_BAR;
    PG8_STAGE(PG8_SB(1, 0), cB + kstep, voffB); PG8_STAGE(PG8_SA(1, 0), cA + kstep, voffA); PG8_STAGE(PG8_SB(1, 1), cB + hstep + kstep, voffB);
    PG8_WAIT_V(6); PG8_BAR;
    for (;;) {
        const bool has_next = S.next(ui + 1, nxt);
        const char* nA = has_next ? (const char*)g.A + (size_t)nxt.pm * tstep : cA; const char* nB = has_next ? (const char*)g.Bt + (size_t)nxt.pn * tstep : cB;
        for (int t = 0; t < nt; t += 2) {
            const bool last = (t == nt - 2);
            const char* a1 = cA + (size_t)(t + 1) * kstep;
            const char* a2 = last ? nA : cA + (size_t)(t + 2) * kstep; const char* b2 = last ? nB : cB + (size_t)(t + 2) * kstep;
            const char* a3 = a2 + kstep; const char* b3 = b2 + kstep;
            if (last && has_next) S.a_ready(nxt);
            PG8_LDB(B0, 0, 0); PG8_SCHED; PG8_LDA(At, 0, 0); PG8_STAGE(PG8_SA(1, 1), a1 + hstep, voffA);
            PG8_WAIT_L(8); PG8_BAR; PG8_WAIT_L(0); PG8_MMA(0, 0, At, B0); PG8_BAR; PG8_SCHED;
            PG8_LDB(B1, 0, 1); PG8_STAGE(PG8_SB(0, 0), b2, voffB);
            PG8_BAR; PG8_WAIT_L(0); PG8_MMA(0, 1, At, B1); PG8_BAR;
            PG8_LDA(At, 0, 1); PG8_STAGE(PG8_SA(0, 0), a2, voffA);
            PG8_BAR; PG8_WAIT_L(0); PG8_MMA(1, 0, At, B0); PG8_BAR; PG8_SCHED;
            PG8_STAGE(PG8_SB(0, 1), b2 + hstep, voffB);
            PG8_WAIT_V(6); PG8_BAR; PG8_MMA(1, 1, At, B1); PG8_BAR;
            PG8_LDB(B0, 1, 0); PG8_SCHED; PG8_LDA(At, 1, 0); PG8_STAGE(PG8_SA(0, 1), a2 + hstep, voffA);
            PG8_WAIT_L(8); PG8_BAR; PG8_WAIT_L(0); PG8_MMA(0, 0, At, B0); PG8_BAR; PG8_SCHED;
            PG8_LDB(B1, 1, 1); PG8_STAGE(PG8_SB(1, 0), b3, voffB);
            PG8_BAR; PG8_WAIT_L(0); PG8_MMA(0, 1, At, B1); PG8_BAR;
            PG8_LDA(At, 1, 1); PG8_STAGE(PG8_SA(1, 0), a3, voffA);
            PG8_BAR; PG8_WAIT_L(0); PG8_MMA(1, 0, At, B0); PG8_BAR; PG8_SCHED;
            PG8_STAGE(PG8_SB(1, 1), b3 + hstep, voffB);
            PG8_WAIT_V(6); PG8_BAR; PG8_MMA(1, 1, At, B1); PG8_BAR;
        }
        if constexpr (!Epi::AFTER_DRAIN) { E(acc, cur, wr, wc, fr, fq); S.done(cur); }
        if (!has_next) break;
#pragma unroll
        for (int a = 0; a < 2; ++a)
#pragma unroll
            for (int b = 0; b < 2; ++b)
#pragma unroll
                for (int m = 0; m < 4; ++m)
#pragma unroll
                    for (int n = 0; n < 2; ++n) acc[a][b][m][n] = (f32x4){0.f, 0.f, 0.f, 0.f};
        cur = nxt; cA = nA; cB = nB; ++ui;
    }
    PG8_WAIT_V(0);
    if (wr == 0) PG8_BAR;
    PG8_BAR;
    if constexpr (Epi::AFTER_DRAIN) { E.fused(acc, cur, wr, wc, fr, fq, lds, wid, lane); S.done(cur); }
#undef PG8_SA
#undef PG8_SB
#undef PG8_STAGE
#undef PG8_LDA
#undef PG8_LDB
#undef PG8_MMA
#undef PG8_WAIT_V
#undef PG8_WAIT_L
#undef PG8_BAR
#undef PG8_SCHED
}
}

#define LAS __attribute__((address_space(3)))
typedef unsigned short bf16_t;
typedef float f32x4 __attribute__((ext_vector_type(4)));
typedef unsigned u32x4 __attribute__((ext_vector_type(4)));
typedef unsigned u32x2 __attribute__((ext_vector_type(2)));
constexpr int M_ = 32768, D_ = 1024, F_ = 2816, T_ = 8192;
constexpr int NTHREADS = 512;
constexpr int LDS_BYTES = 131072 + 16;
constexpr size_t SZ_TOK512 = (size_t)M_ * 512 * 2;
constexpr size_t WS_BAR = 0;
constexpr size_t WS_MOD = 16384;
constexpr size_t WS_FMOD = WS_MOD + 4 * 9216 * 4;
constexpr size_t WS_WGU1 = WS_FMOD + 4 * 2048 * 4;
constexpr size_t WS_WD1 = WS_WGU1 + (size_t)5632 * 1024 * 2;
constexpr size_t WS_WGU2 = WS_WD1 + (size_t)1024 * 2816 * 2;
constexpr size_t WS_WD2 = WS_WGU2 + (size_t)5632 * 1024 * 2;
constexpr size_t WS_WINC = WS_WD2 + (size_t)1024 * 2816 * 2;
constexpr size_t WS_WINR = WS_WINC + (size_t)1536 * 1024 * 2;
constexpr size_t WS_WLORA = WS_WINR + (size_t)1792 * 1024 * 2;
constexpr size_t WS_WOUT = WS_WLORA + (size_t)2560 * 256 * 2;
constexpr size_t WS_H = WS_WOUT + (size_t)1024 * 1024 * 2;
constexpr size_t WS_YMIX = WS_H + (size_t)M_ * 1024 * 2;
constexpr size_t WS_BIG = WS_YMIX + (size_t)M_ * 1024 * 2;
constexpr size_t WS_EXTRA = WS_BIG + (size_t)M_ * 3328 * 2;
constexpr size_t WS_END = WS_EXTRA + 3 * SZ_TOK512 + (size_t)M_ * 256 * 2;
constexpr size_t WS_HID = WS_BIG;
constexpr size_t WS_PROJC = WS_BIG;
constexpr size_t WS_PROJR = WS_BIG + (size_t)M_ * 1536 * 2;
constexpr size_t WS_OUT5 = WS_BIG;
constexpr size_t WS_YS1 = WS_BIG + 5 * SZ_TOK512;
constexpr size_t WS_R = WS_H;
constexpr size_t WS_K = WS_H + SZ_TOK512;
constexpr size_t WS_V = WS_EXTRA;
constexpr size_t WS_KK = WS_EXTRA + SZ_TOK512;
constexpr size_t WS_AP = WS_EXTRA + 2 * SZ_TOK512;
constexpr size_t WS_YS0 = WS_AP + (size_t)M_ * 256 * 2;
static_assert(WS_END <= 536870912ull, "workspace");

struct Params {
    const float* in[31];
    float* out; unsigned char* ws;
    int ph_lo, ph_hi, coop, pad;
};

__device__ __forceinline__ float sigm(float x) { return __builtin_amdgcn_rcpf(1.0f + __builtin_amdgcn_exp2f(-1.44269504f * x)); }
__device__ __forceinline__ unsigned pk_bf16(float lo, float hi) { return pg8::cvt_pk_bf16(lo, hi); }
__device__ __forceinline__ unsigned pk_f16(float lo, float hi) { typedef _Float16 h2 __attribute__((ext_vector_type(2))); h2 v; v.x = (_Float16)lo; v.y = (_Float16)hi; return __builtin_bit_cast(unsigned, v); }
__device__ __forceinline__ float bf_lo(unsigned w) { return __uint_as_float(w << 16); }
__device__ __forceinline__ float bf_hi(unsigned w) { return __uint_as_float(w & 0xffff0000u); }
__device__ __forceinline__ float h_lo(unsigned w) { typedef _Float16 h2 __attribute__((ext_vector_type(2))); h2 v = __builtin_bit_cast(h2, w); return (float)v.x; }
__device__ __forceinline__ float h_hi(unsigned w) { typedef _Float16 h2 __attribute__((ext_vector_type(2))); h2 v = __builtin_bit_cast(h2, w); return (float)v.y; }
__device__ __forceinline__ void unpack8_bf(const u32x4 w, float (&f)[8]) { f[0] = bf_lo(w.x); f[1] = bf_hi(w.x); f[2] = bf_lo(w.y); f[3] = bf_hi(w.y); f[4] = bf_lo(w.z); f[5] = bf_hi(w.z); f[6] = bf_lo(w.w); f[7] = bf_hi(w.w); }
__device__ __forceinline__ void unpack8_h(const u32x4 w, float (&f)[8]) { f[0] = h_lo(w.x); f[1] = h_hi(w.x); f[2] = h_lo(w.y); f[3] = h_hi(w.y); f[4] = h_lo(w.z); f[5] = h_hi(w.z); f[6] = h_lo(w.w); f[7] = h_hi(w.w); }
__device__ __forceinline__ u32x4 pack8_bf(const float (&f)[8]) { u32x4 w; w.x = pk_bf16(f[0], f[1]); w.y = pk_bf16(f[2], f[3]); w.z = pk_bf16(f[4], f[5]); w.w = pk_bf16(f[6], f[7]); return w; }
__device__ __forceinline__ void load8_bf(const bf16_t* p, float (&f)[8]) { unpack8_bf(*(const u32x4*)p, f); }

namespace pg8 {
struct EpiGen {
    static constexpr bool PERM = true, AFTER_DRAIN = false;
    int mode;
    bf16_t* O; int ldo;
    const float* base; float* out; const float* gate; float gscale;
    const float* w0; const float* a0;
    __device__ __forceinline__ void operator()(const f32x4 (&acc)[2][2][4][2], const Unit& u, int wr, int wc, int fr, int fq) const {
        const int row0 = u.pm * BM + wr * 64 + fr;
        if (mode == 1) {
            const int col0 = u.pn * 128 + wc * 32 + 8 * fq;
#pragma unroll
            for (int ai = 0; ai < 2; ++ai)
#pragma unroll
                for (int m = 0; m < 4; ++m) {
                    const f32x4 g0 = acc[ai][0][m][0], g1 = acc[ai][0][m][1], u0 = acc[ai][1][m][0], u1 = acc[ai][1][m][1];
                    float h[8];
#pragma unroll
                    for (int j = 0; j < 4; ++j) { h[j] = g0[j] * sigm(g0[j]) * u0[j]; h[4 + j] = g1[j] * sigm(g1[j]) * u1[j]; }
                    *(u32x4*)(O + (size_t)(row0 + ai * HALF + m * 16) * ldo + col0) = pack8_bf(h);
                }
        } else if (mode == 0) {
            const int col0 = u.pn * BM + wc * 32 + 8 * fq;
#pragma unroll
            for (int ai = 0; ai < 2; ++ai)
#pragma unroll
                for (int m = 0; m < 4; ++m)
#pragma unroll
                    for (int bj = 0; bj < 2; ++bj) {
                        const f32x4 v0 = acc[ai][bj][m][0], v1 = acc[ai][bj][m][1];
                        u32x4 w; w.x = cvt_pk_bf16(v0[0], v0[1]); w.y = cvt_pk_bf16(v0[2], v0[3]); w.z = cvt_pk_bf16(v1[0], v1[1]); w.w = cvt_pk_bf16(v1[2], v1[3]);
                        *(u32x4*)(O + (size_t)(row0 + ai * HALF + m * 16) * ldo + col0 + bj * HALF) = w;
                    }
        } else if (mode == 2) {
            const int b = u.pm >> 5;
            const int col0 = u.pn * BM + wc * 32 + 8 * fq;
            f32x4 gv[2][2];
#pragma unroll
            for (int bj = 0; bj < 2; ++bj)
#pragma unroll
                for (int n = 0; n < 2; ++n) gv[bj][n] = *(const f32x4*)(gate + (size_t)b * 9216 + col0 + bj * HALF + 4 * n) * gscale;
            f32x4 bs[3][2][2];
#define RES_LOAD(it) do { const size_t off_ = (size_t)(row0 + ((it) >> 2) * HALF + ((it) & 3) * 16) * 1024 + col0; \
                _Pragma("unroll") for (int bj = 0; bj < 2; ++bj) _Pragma("unroll") for (int n = 0; n < 2; ++n) bs[(it) % 3][bj][n] = *(const f32x4*)(base + off_ + bj * HALF + 4 * n); } while (0)
            RES_LOAD(0); RES_LOAD(1);
#pragma unroll
            for (int it = 0; it < 8; ++it) {
                if (it + 2 < 8) RES_LOAD(it + 2);
                const size_t off = (size_t)(row0 + (it >> 2) * HALF + (it & 3) * 16) * 1024 + col0;
#pragma unroll
                for (int bj = 0; bj < 2; ++bj)
#pragma unroll
                    for (int n = 0; n < 2; ++n) *(f32x4*)(out + off + bj * HALF + 4 * n) = bs[it % 3][bj][n] + gv[bj][n] * acc[it >> 2][bj][it & 3][n];
            }
#undef RES_LOAD
        } else {
            const int arr = u.pn >> 1;
            const int colt = (u.pn & 1) * 256 + wc * 32 + 8 * fq;
            bf16_t* Ob = O + (size_t)arr * ((size_t)32768 * 512);
            f32x4 bv[2][2];
#pragma unroll
            for (int bj = 0; bj < 2; ++bj)
#pragma unroll
                for (int n = 0; n < 2; ++n) {
                    const int c = colt + bj * HALF + 4 * n;
                    bv[bj][n] = arr < 2 ? *(const f32x4*)(w0 + arr * 512 + c) : (arr < 4 ? *(const f32x4*)(a0 + (arr - 2) * 512 + c) : (f32x4){0.f, 0.f, 0.f, 0.f});
                }
#pragma unroll
            for (int ai = 0; ai < 2; ++ai)
#pragma unroll
                for (int m = 0; m < 4; ++m)
#pragma unroll
                    for (int bj = 0; bj < 2; ++bj) {
                        f32x4 v0 = acc[ai][bj][m][0] + bv[bj][0], v1 = acc[ai][bj][m][1] + bv[bj][1];
                        u32x4 w;
                        if (arr < 4) {
                            const float sc = arr < 2 ? 0.87503877f : 1.0f;
#pragma unroll
                            for (int j = 0; j < 4; ++j) { v0[j] = sc * sigm(v0[j]); v1[j] = sc * sigm(v1[j]); }
                            w.x = pk_f16(v0[0], v0[1]); w.y = pk_f16(v0[2], v0[3]); w.z = pk_f16(v1[0], v1[1]); w.w = pk_f16(v1[2], v1[3]);
                        } else {
                            w.x = cvt_pk_bf16(v0[0], v0[1]); w.y = cvt_pk_bf16(v0[2], v0[3]); w.z = cvt_pk_bf16(v1[0], v1[1]); w.w = cvt_pk_bf16(v1[2], v1[3]);
                        }
                        *(u32x4*)(Ob + (size_t)(row0 + ai * HALF + m * 16) * 512 + colt + bj * HALF) = w;
                    }
        }
    }
};
}

__device__ __forceinline__ float wave_sum64(float v) {
#pragma unroll
    for (int o = 32; o >= 1; o >>= 1) v += __shfl_xor(v, o);
    return v;
}
__device__ __forceinline__ float sum8(float v) { v += __shfl_xor(v, 1); v += __shfl_xor(v, 2); v += __shfl_xor(v, 4); return v; }

__device__ __forceinline__ void p0_prologue(const Params& p, LAS unsigned char* lds, const int tid) {
    unsigned char* ws = p.ws;
    LAS float* sc = (LAS float*)lds;
    LAS float* red = (LAS float*)(lds + 16384);
    {
        const float* c = p.in[1];
        for (int i = tid; i < 4096; i += NTHREADS) { const float v = c[i]; sc[i] = v * sigm(v); }
    }
    __syncthreads();
    for (int cb = blockIdx.x; cb < 176; cb += gridDim.x) {
        const int cc = tid & 63, dg = tid >> 6, col = cb * 64 + cc;
        const float* W; const float* bias; float* dst; int ld, jc;
        if (col < 9216) { W = p.in[2]; bias = p.in[3]; dst = (float*)(ws + WS_MOD); ld = 9216; jc = col; }
        else { W = p.in[28]; bias = p.in[29]; dst = (float*)(ws + WS_FMOD); ld = 2048; jc = col - 9216; }
        float a0 = 0.f, a1 = 0.f, a2 = 0.f, a3 = 0.f;
        const float* wp = W + (size_t)(dg * 128) * ld + jc;
#pragma unroll 8
        for (int d = 0; d < 128; ++d) {
            const float w = wp[(size_t)d * ld]; const int dd = dg * 128 + d;
            a0 += sc[dd] * w; a1 += sc[1024 + dd] * w; a2 += sc[2048 + dd] * w; a3 += sc[3072 + dd] * w;
        }
        red[(dg * 64 + cc) * 4 + 0] = a0; red[(dg * 64 + cc) * 4 + 1] = a1; red[(dg * 64 + cc) * 4 + 2] = a2; red[(dg * 64 + cc) * 4 + 3] = a3;
        __syncthreads();
        if (tid < 256) {
            const int b = tid >> 6, c2 = tid & 63;
            float s = 0.f;
#pragma unroll
            for (int g = 0; g < 8; ++g) s += red[(g * 64 + c2) * 4 + b];
            const int col2 = cb * 64 + c2; const int jc2 = col2 < 9216 ? col2 : col2 - 9216;
            dst[(size_t)b * ld + jc2] = s + bias[jc2];
        }
        __syncthreads();
    }
    LAS float* tile = (LAS float*)(lds + 32768);
    for (int ti = blockIdx.x; ti < 5312; ti += gridDim.x) {
        int job, r;
        if (ti < 4224) { job = ti / 704; r = ti % 704; } else if (ti < 5056) { job = 6; r = ti - 4224; } else { job = 7; r = ti - 5056; }
        const float* W; int K, N;
        switch (job) {
            case 0: W = p.in[5]; K = 1024; N = 2816; break;
            case 1: W = p.in[6]; K = 1024; N = 2816; break;
            case 2: W = p.in[7]; K = 2816; N = 1024; break;
            case 3: W = p.in[25]; K = 1024; N = 2816; break;
            case 4: W = p.in[26]; K = 1024; N = 2816; break;
            case 5: W = p.in[27]; K = 2816; N = 1024; break;
            case 6: W = p.in[9]; K = 1024; N = 3328; break;
            default: W = p.in[23]; K = 1024; N = 1024; break;
        }
        const int nkt = K / 64, kt = r % nkt, ntile = r / nkt;
        {
            const int c = tid & 63, r0 = tid >> 6;
#pragma unroll
            for (int i = 0; i < 8; ++i) { const int kr = i * 8 + r0; tile[kr * 65 + c] = W[(size_t)(kt * 64 + kr) * N + ntile * 64 + c]; }
        }
        __syncthreads();
        {
            const int nl = tid >> 3, k8 = (tid & 7) * 8, n = ntile * 64 + nl;
            bf16_t* dst; int row;
            switch (job) {
                case 0: dst = (bf16_t*)(ws + WS_WGU1); row = 256 * (n >> 7) + (n & 127); break;
                case 1: dst = (bf16_t*)(ws + WS_WGU1); row = 256 * (n >> 7) + 128 + (n & 127); break;
                case 2: dst = (bf16_t*)(ws + WS_WD1); row = n; break;
                case 3: dst = (bf16_t*)(ws + WS_WGU2); row = 256 * (n >> 7) + (n & 127); break;
                case 4: dst = (bf16_t*)(ws + WS_WGU2); row = 256 * (n >> 7) + 128 + (n & 127); break;
                case 5: dst = (bf16_t*)(ws + WS_WD2); row = n; break;
                case 6: if (n < 1536) { dst = (bf16_t*)(ws + WS_WINC); row = n; } else { dst = (bf16_t*)(ws + WS_WINR); row = n - 1536; } break;
                default: dst = (bf16_t*)(ws + WS_WOUT); row = n; break;
            }
            float f[8];
#pragma unroll
            for (int q = 0; q < 8; ++q) f[q] = tile[(k8 + q) * 65 + nl];
            *(u32x4*)(dst + (size_t)row * K + kt * 64 + k8) = pack8_bf(f);
        }
        __syncthreads();
    }
    {
        bf16_t* WL = (bf16_t*)(ws + WS_WLORA);
        const float* w_up = p.in[14]; const float* a_up = p.in[16]; const float* g_up = p.in[17];
        for (int idx = blockIdx.x * NTHREADS + tid; idx < 2560 * 256; idx += gridDim.x * NTHREADS) {
            const int n = idx % 2560, k = idx / 2560;
            float val = 0.f;
            if (n < 1024) { const int d = n >> 9, c = n & 511; if (k < 64) val = w_up[(size_t)(d * 64 + k) * 512 + c]; }
            else if (n < 2048) { const int n2 = n - 1024, d = n2 >> 9, c = n2 & 511; if (k >= 64 && k < 128) val = a_up[(size_t)(d * 64 + k - 64) * 512 + c]; }
            else { const int c = n - 2048; if (k >= 128) val = g_up[(size_t)(k - 128) * 512 + c]; }
            WL[(size_t)n * 256 + k] = (bf16_t)(pk_bf16(val, val) & 0xffffu);
        }
    }
}

template <bool FINAL>
__device__ __forceinline__ void modulate_phase(const float* X, const float* gvec, const float* shift, const float* scale, int mod_ld, bf16_t* outH, float* outF, const int tid,
                                               const bf16_t* delta = nullptr, const float* dgate = nullptr) {
    const int lane = tid & 63, wid = tid >> 6;
    const int gw = blockIdx.x * 8 + wid, nw = gridDim.x * 8;
    f32x4 g4[4];
#pragma unroll
    for (int i = 0; i < 4; ++i) g4[i] = *(const f32x4*)(gvec + i * 256 + lane * 4);
    f32x4 x4[4], xn[4];
    if (gw < M_) {
#pragma unroll
        for (int i = 0; i < 4; ++i) x4[i] = *(const f32x4*)(X + (size_t)gw * 1024 + i * 256 + lane * 4);
    }
    for (int row = gw; row < M_; row += nw) {
        const int b = row >> 13;
        f32x4 sc4[4], sh4[4], gt[4]; u32x2 dw[4];
#pragma unroll
        for (int i = 0; i < 4; ++i) {
            sc4[i] = *(const f32x4*)(scale + (size_t)b * mod_ld + i * 256 + lane * 4);
            sh4[i] = *(const f32x4*)(shift + (size_t)b * mod_ld + i * 256 + lane * 4);
            if (FINAL) { dw[i] = *(const u32x2*)(delta + (size_t)row * 1024 + i * 256 + lane * 4); gt[i] = *(const f32x4*)(dgate + (size_t)b * 9216 + i * 256 + lane * 4); }
        }
        const int nrow = row + nw;
        if (nrow < M_) {
#pragma unroll
            for (int i = 0; i < 4; ++i) xn[i] = *(const f32x4*)(X + (size_t)nrow * 1024 + i * 256 + lane * 4);
        }
        float ss = 0.f;
#pragma unroll
        for (int i = 0; i < 4; ++i) {
            if (FINAL) x4[i] += (gt[i] * 0.5f) * (f32x4){bf_lo(dw[i].x), bf_hi(dw[i].x), bf_lo(dw[i].y), bf_hi(dw[i].y)};
            ss += x4[i][0] * x4[i][0] + x4[i][1] * x4[i][1] + x4[i][2] * x4[i][2] + x4[i][3] * x4[i][3];
        }
        ss = wave_sum64(ss);
        const float rstd = __builtin_amdgcn_rsqf(ss * (1.0f / 1024.0f) + 1e-6f);
#pragma unroll
        for (int i = 0; i < 4; ++i) {
            const f32x4 y = (x4[i] * rstd) * g4[i] * (sc4[i] + 1.0f) + sh4[i];
            if (FINAL) *(f32x4*)(outF + (size_t)row * 1024 + i * 256 + lane * 4) = y;
            else { u32x2 w; w.x = pk_bf16(y[0], y[1]); w.y = pk_bf16(y[2], y[3]); *(u32x2*)(outH + (size_t)row * 1024 + i * 256 + lane * 4) = w; }
        }
#pragma unroll
        for (int i = 0; i < 4; ++i) x4[i] = xn[i];
    }
}

__device__ __forceinline__ void prep_phase(const Params& p, const int tid) {
    const int lane = tid & 63, wid = tid >> 6;
    const int gw = blockIdx.x * 8 + wid, nw = gridDim.x * 8;
    unsigned char* ws = p.ws;
    const int c0 = lane * 8;
    {
        const bf16_t* PC = (const bf16_t*)(ws + WS_PROJC);
        bf16_t* YM = (bf16_t*)(ws + WS_YMIX);
        float cw0[8], cw1[8], cw2[8], cbv[8];
#pragma unroll
        for (int q = 0; q < 8; ++q) { cw0[q] = p.in[10][c0 + q]; cw1[q] = p.in[10][512 + c0 + q]; cw2[q] = p.in[10][1024 + c0 + q]; cbv[q] = p.in[11][c0 + q]; }
        for (int task = gw; task < M_ / 16; task += nw) {
            const int t0 = task * 16, tl0 = t0 & (T_ - 1);
            float up[8], uc[8], un[8], a[8], b[8];
            if (tl0 == 0) {
#pragma unroll
                for (int q = 0; q < 8; ++q) up[q] = 0.f;
            } else {
                load8_bf(PC + (size_t)(t0 - 1) * 1536 + 512 + c0, a); load8_bf(PC + (size_t)(t0 - 1) * 1536 + 1024 + c0, b);
#pragma unroll
                for (int q = 0; q < 8; ++q) up[q] = a[q] * b[q];
            }
            load8_bf(PC + (size_t)t0 * 1536 + 512 + c0, a); load8_bf(PC + (size_t)t0 * 1536 + 1024 + c0, b);
#pragma unroll
            for (int q = 0; q < 8; ++q) uc[q] = a[q] * b[q];
            for (int i = 0; i < 16; ++i) {
                const int tok = t0 + i;
                if (tl0 + i + 1 < T_) {
                    load8_bf(PC + (size_t)(tok + 1) * 1536 + 512 + c0, a); load8_bf(PC + (size_t)(tok + 1) * 1536 + 1024 + c0, b);
#pragma unroll
                    for (int q = 0; q < 8; ++q) un[q] = a[q] * b[q];
                } else {
#pragma unroll
                    for (int q = 0; q < 8; ++q) un[q] = 0.f;
                }
                float cbr[8], y[8];
                load8_bf(PC + (size_t)tok * 1536 + c0, cbr);
#pragma unroll
                for (int q = 0; q < 8; ++q) y[q] = cbr[q] * (cw0[q] * up[q] + cw1[q] * uc[q] + cw2[q] * un[q] + cbv[q]);
                *(u32x4*)(YM + (size_t)tok * 1024 + c0) = pack8_bf(y);
#pragma unroll
                for (int q = 0; q < 8; ++q) { up[q] = uc[q]; uc[q] = un[q]; }
            }
        }
    }
    {
        const bf16_t* PR = (const bf16_t*)(ws + WS_PROJR);
        bf16_t* Ro = (bf16_t*)(ws + WS_R); bf16_t* Ko = (bf16_t*)(ws + WS_K); bf16_t* Vo = (bf16_t*)(ws + WS_V); bf16_t* KKo = (bf16_t*)(ws + WS_KK); bf16_t* APo = (bf16_t*)(ws + WS_AP);
        const float* mu = p.in[12]; const float* k_k = p.in[18];
        float mur[8], muk[8], muv[8], mus[4], kkw[8];
#pragma unroll
        for (int q = 0; q < 8; ++q) { mur[q] = mu[c0 + q]; muk[q] = mu[512 + c0 + q]; muv[q] = mu[1024 + c0 + q]; kkw[q] = k_k[c0 + q]; }
#pragma unroll
        for (int q = 0; q < 4; ++q) mus[q] = mu[1536 + lane * 4 + q];
        for (int task = gw; task < M_ / 16; task += nw) {
            const int t0 = task * 16, tl0 = t0 & (T_ - 1);
            float pr[8], pk[8], pv[8], ps[4], cr[8], ck[8], cv[8], cs[4], nr[8], nk[8], nv[8], ns[4];
            if (tl0 == 0) {
#pragma unroll
                for (int q = 0; q < 8; ++q) { pr[q] = 0.f; pk[q] = 0.f; pv[q] = 0.f; }
#pragma unroll
                for (int q = 0; q < 4; ++q) ps[q] = 0.f;
            } else {
                const bf16_t* b = PR + (size_t)(t0 - 1) * 1792;
                load8_bf(b + c0, pr); load8_bf(b + 512 + c0, pk); load8_bf(b + 1024 + c0, pv);
                const u32x2 w = *(const u32x2*)(b + 1536 + lane * 4); ps[0] = bf_lo(w.x); ps[1] = bf_hi(w.x); ps[2] = bf_lo(w.y); ps[3] = bf_hi(w.y);
            }
            {
                const bf16_t* b = PR + (size_t)t0 * 1792;
                load8_bf(b + c0, cr); load8_bf(b + 512 + c0, ck); load8_bf(b + 1024 + c0, cv);
                const u32x2 w = *(const u32x2*)(b + 1536 + lane * 4); cs[0] = bf_lo(w.x); cs[1] = bf_hi(w.x); cs[2] = bf_lo(w.y); cs[3] = bf_hi(w.y);
            }
            for (int i = 0; i < 16; ++i) {
                const int tok = t0 + i;
                if (tl0 + i + 1 < T_) {
                    const bf16_t* b = PR + (size_t)(tok + 1) * 1792;
                    load8_bf(b + c0, nr); load8_bf(b + 512 + c0, nk); load8_bf(b + 1024 + c0, nv);
                    const u32x2 w = *(const u32x2*)(b + 1536 + lane * 4); ns[0] = bf_lo(w.x); ns[1] = bf_hi(w.x); ns[2] = bf_lo(w.y); ns[3] = bf_hi(w.y);
                } else {
#pragma unroll
                    for (int q = 0; q < 8; ++q) { nr[q] = 0.f; nk[q] = 0.f; nv[q] = 0.f; }
#pragma unroll
                    for (int q = 0; q < 4; ++q) ns[q] = 0.f;
                }
                float rs[8], ks[8], vs[8], kkv[8], ss = 0.f;
#pragma unroll
                for (int q = 0; q < 8; ++q) {
                    rs[q] = cr[q] + mur[q] * (0.5f * (pr[q] + nr[q]) - cr[q]);
                    ks[q] = ck[q] + muk[q] * (0.5f * (pk[q] + nk[q]) - ck[q]);
                    vs[q] = cv[q] + muv[q] * (0.5f * (pv[q] + nv[q]) - cv[q]);
                    kkv[q] = ks[q] * kkw[q]; ss += kkv[q] * kkv[q];
                }
                ss = sum8(ss);
                const float rn = __builtin_amdgcn_rsqf(ss + 1e-12f);
#pragma unroll
                for (int q = 0; q < 8; ++q) kkv[q] *= rn;
                *(u32x4*)(Ro + (size_t)tok * 512 + c0) = pack8_bf(rs);
                *(u32x4*)(Ko + (size_t)tok * 512 + c0) = pack8_bf(ks);
                *(u32x4*)(Vo + (size_t)tok * 512 + c0) = pack8_bf(vs);
                *(u32x4*)(KKo + (size_t)tok * 512 + c0) = pack8_bf(kkv);
                float sv[4];
#pragma unroll
                for (int q = 0; q < 4; ++q) {
                    const float s = cs[q] + mus[q] * (0.5f * (ps[q] + ns[q]) - cs[q]);
                    const float th = 2.0f * sigm(2.0f * s) - 1.0f, sg = sigm(s);
                    sv[q] = lane < 16 ? th : (lane < 32 ? s : sg);
                }
                { u32x2 w; w.x = pk_bf16(sv[0], sv[1]); w.y = pk_bf16(sv[2], sv[3]); *(u32x2*)(APo + (size_t)tok * 256 + lane * 4) = w; }
#pragma unroll
                for (int q = 0; q < 8; ++q) { pr[q] = cr[q]; pk[q] = ck[q]; pv[q] = cv[q]; cr[q] = nr[q]; ck[q] = nk[q]; cv[q] = nv[q]; }
#pragma unroll
                for (int q = 0; q < 4; ++q) { ps[q] = cs[q]; cs[q] = ns[q]; }
            }
        }
    }
}

typedef float f32x2 __attribute__((ext_vector_type(2)));
template <int CTRL> __device__ __forceinline__ float dpp_add(float x) { return x + __int_as_float(__builtin_amdgcn_update_dpp(0, __float_as_int(x), CTRL, 0xf, 0xf, false)); }
__device__ __forceinline__ float allsum16(float x) { x = dpp_add<0x121>(x); x = dpp_add<0x122>(x); x = dpp_add<0x124>(x); x = dpp_add<0x128>(x); return x; }
#define SCAN_BAR() asm volatile("s_waitcnt lgkmcnt(0)\n\ts_barrier" ::: "memory")
constexpr int SC_STEP = 1024, SC_CH = 64, SC_BUF = SC_STEP * SC_CH, SC_NCH = T_ / SC_CH;
typedef _Float16 h8 __attribute__((ext_vector_type(8)));
struct ScanOps { f32x4 W; u32x4 KKWR, KKAKD; f32x4 VC; };
template <int S> __device__ __forceinline__ void scan_ld(ScanOps& o, const unsigned bp, const unsigned vp) {
    asm volatile("ds_read_b128 %0, %1 offset:%2" : "=v"(o.KKWR) : "v"(bp), "n"(S * SC_STEP + 256));
    asm volatile("ds_read_b128 %0, %1 offset:%2" : "=v"(o.VC) : "v"(vp), "n"(S * SC_STEP));
    asm volatile("ds_read_b128 %0, %1 offset:%2" : "=v"(o.W) : "v"(bp), "n"(S * SC_STEP));
    asm volatile("ds_read_b128 %0, %1 offset:%2" : "=v"(o.KKAKD) : "v"(bp), "n"(S * SC_STEP + 512));
}
template <int N> __device__ __forceinline__ void scan_wait(ScanOps& o) {
    asm volatile("s_waitcnt lgkmcnt(%4)" : "+v"(o.W), "+v"(o.KKWR), "+v"(o.KKAKD), "+v"(o.VC) : "n"(N));
}
__device__ __forceinline__ float scan_step(float (&st)[4], const ScanOps& o) {
    const h8 a = __builtin_bit_cast(h8, o.KKWR), b = __builtin_bit_cast(h8, o.KKAKD);
    const float v = o.VC[0];
    float pa = __builtin_fmaf(st[0], (float)a[0], o.VC[3]); pa = __builtin_fmaf(st[1], (float)a[1], pa); pa = __builtin_fmaf(st[2], (float)a[2], pa);
    float pb = __builtin_fmaf(st[0], (float)a[4], o.VC[1]); pb = __builtin_fmaf(st[1], (float)a[5], pb); pb = __builtin_fmaf(st[2], (float)a[6], pb);
    float sa = __builtin_fmaf(st[3], (float)a[3], pa);
    const float pp = __builtin_fmaf(st[3], (float)a[7], pb);
    const float m0 = st[0] * o.W[0], m1 = st[1] * o.W[1];
    sa = dpp_add<0x121>(sa);
    const float m2 = st[2] * o.W[2], m3 = st[3] * o.W[3];
    sa = dpp_add<0x122>(sa);
    const float t0 = __builtin_fmaf((float)b[4], v, m0), t1 = __builtin_fmaf((float)b[5], v, m1);
    sa = dpp_add<0x124>(sa);
    const float t2 = __builtin_fmaf((float)b[6], v, m2), t3 = __builtin_fmaf((float)b[7], v, m3);
    sa = dpp_add<0x128>(sa);
    st[0] = __builtin_fmaf(-(float)b[0], sa, t0); st[1] = __builtin_fmaf(-(float)b[1], sa, t1); st[2] = __builtin_fmaf(-(float)b[2], sa, t2); st[3] = __builtin_fmaf(-(float)b[3], sa, t3);
    return __builtin_fmaf(-sa, o.VC[2], pp);
}
template <int CTRL> __device__ __forceinline__ float dpp_mov(float x) { return __int_as_float(__builtin_amdgcn_update_dpp(0, __float_as_int(x), CTRL, 0xf, 0xf, false)); }
__device__ __forceinline__ float transpose_reduce16(float (&p)[16], const int j) {
#define TR_A(lo, hi) asm volatile("v_add_f32_dpp %0, %0, %0 row_ror:8 row_mask:0xf bank_mask:0xc\n\tv_add_f32_dpp %0, %1, %1 row_ror:8 row_mask:0xf bank_mask:0x3" : "+v"(hi) : "v"(lo))
#define TR_AN(lo, hi) asm volatile("s_nop 1\n\tv_add_f32_dpp %0, %0, %0 row_ror:8 row_mask:0xf bank_mask:0xc\n\tv_add_f32_dpp %0, %1, %1 row_ror:8 row_mask:0xf bank_mask:0x3" : "+v"(hi) : "v"(lo))
    TR_A(p[0], p[8]); TR_A(p[1], p[9]); TR_A(p[2], p[10]); TR_A(p[3], p[11]); TR_A(p[4], p[12]); TR_AN(p[5], p[13]); TR_AN(p[6], p[14]); TR_AN(p[7], p[15]);
#undef TR_A
#undef TR_AN
#define TR_B(lo, hi) asm volatile("v_add_f32_dpp %0, %0, %0 row_ror:4 row_mask:0xf bank_mask:0xa\n\tv_add_f32_dpp %0, %1, %1 row_ror:12 row_mask:0xf bank_mask:0x5" : "+v"(hi) : "v"(lo))
    TR_B(p[8], p[12]); TR_B(p[9], p[13]); TR_B(p[10], p[14]); TR_B(p[11], p[15]);
#undef TR_B
    const bool b1 = (j & 2) != 0, b0 = (j & 1) != 0;
    float q0, q1;
    { const float keep = b1 ? p[14] : p[12], send = b1 ? p[12] : p[14]; q0 = keep + dpp_mov<0x4E>(send); }
    { const float keep = b1 ? p[15] : p[13], send = b1 ? p[13] : p[15]; q1 = keep + dpp_mov<0x4E>(send); }
    const float keep = b0 ? q1 : q0, send = b0 ? q0 : q1;
    return keep + dpp_mov<0xB1>(send);
}
template <int S> __device__ __forceinline__ void scan_pair(float (&st)[4], float (&pacc)[16], ScanOps& A, ScanOps& B, const unsigned bp, const unsigned vp, const int j,
                                                          bf16_t* const yrow, const long ystep) {
    scan_ld<S + 1>(B, bp, vp);
    scan_wait<4>(A);
    pacc[S & 15] = scan_step(st, A);
    if constexpr (S + 2 < SC_CH) { scan_ld<S + 2>(A, bp, vp); scan_wait<4>(B); } else { scan_wait<0>(B); }
    pacc[(S + 1) & 15] = scan_step(st, B);
    if constexpr (((S + 2) & 15) == 0) {
        const float y = transpose_reduce16(pacc, j);
        yrow[(long)((S + 2) / 16 - 1) * 16 * ystep] = (bf16_t)(pk_bf16(y, y) & 0xffffu);
    }
    if constexpr (S + 2 < SC_CH) scan_pair<S + 2>(st, pacc, A, B, bp, vp, j, yrow, ystep);
}

__device__ __forceinline__ void scan_phase(const Params& p, LAS unsigned char* lds, const int tid) {
    const int lane = tid & 63, wid = __builtin_amdgcn_readfirstlane(tid >> 6);
    unsigned char* ws = p.ws;
    const bf16_t* Rg = (const bf16_t*)(ws + WS_R); const bf16_t* Kg = (const bf16_t*)(ws + WS_K); const bf16_t* Vg = (const bf16_t*)(ws + WS_V); const bf16_t* KKg = (const bf16_t*)(ws + WS_KK);
    for (int unit = blockIdx.x; unit < 256; unit += gridDim.x) {
        const int xcd = unit & 7, jj = unit >> 3, seq = xcd * 8 + (jj >> 2), rg = jj & 3;
        const int dir = seq >> 5, b = (seq >> 3) & 3, h = seq & 7;
        const size_t tokbase = (size_t)b * T_; const int ch0 = h * 64;
        const bf16_t* DWg = (const bf16_t*)(ws + WS_OUT5 + (size_t)dir * SZ_TOK512);
        const bf16_t* AAg = (const bf16_t*)(ws + WS_OUT5 + (size_t)(2 + dir) * SZ_TOK512);
        bf16_t* YSg = (bf16_t*)(ws + (dir ? WS_YS1 : WS_YS0));
        if (wid >= 4) {
            const int pt = tid - 256, sl = pt >> 4, kq = pt & 15;
            float ka4[4];
#pragma unroll
            for (int q = 0; q < 4; ++q) ka4[q] = p.in[19][ch0 + 4 * kq + q];
            u32x2 rr[4], kr[4], kkr[4], ar[4], dr[4]; unsigned short vr[4];
#define SC_LOAD(c) do { _Pragma("unroll") for (int e = 0; e < 4; ++e) { const int s = (c) * SC_CH + sl + 16 * e; const int t = dir ? (T_ - 1 - s) : s; \
                const size_t o = (tokbase + t) * 512 + ch0 + 4 * kq; \
                rr[e] = *(const u32x2*)(Rg + o); kr[e] = *(const u32x2*)(Kg + o); kkr[e] = *(const u32x2*)(KKg + o); ar[e] = *(const u32x2*)(AAg + o); dr[e] = *(const u32x2*)(DWg + o); \
                vr[e] = Vg[(tokbase + t) * 512 + ch0 + rg * 16 + kq]; } } while (0)
#define SC_CONV(bufi) do { _Pragma("unroll") for (int e = 0; e < 4; ++e) { LAS unsigned char* bp = lds + (bufi) * SC_BUF + (sl + 16 * e) * SC_STEP; \
                const float r_[4] = {bf_lo(rr[e].x), bf_hi(rr[e].x), bf_lo(rr[e].y), bf_hi(rr[e].y)}; \
                const float k_[4] = {bf_lo(kr[e].x), bf_hi(kr[e].x), bf_lo(kr[e].y), bf_hi(kr[e].y)}; \
                const float q_[4] = {bf_lo(kkr[e].x), bf_hi(kkr[e].x), bf_lo(kkr[e].y), bf_hi(kkr[e].y)}; \
                const float a_[4] = {h_lo(ar[e].x), h_hi(ar[e].x), h_lo(ar[e].y), h_hi(ar[e].y)}; \
                const float d_[4] = {h_lo(dr[e].x), h_hi(dr[e].x), h_lo(dr[e].y), h_hi(dr[e].y)}; \
                f32x4 w4; float kka4[4], kd4[4], wr4[4]; float c1 = 0.f, c2 = 0.f; \
                _Pragma("unroll") for (int q = 0; q < 4; ++q) { w4[q] = __builtin_amdgcn_exp2f(-d_[q]); kka4[q] = q_[q] * a_[q]; kd4[q] = k_[q] * (1.0f + (a_[q] - 1.0f) * ka4[q]); wr4[q] = w4[q] * r_[q]; \
                    c1 += kka4[q] * r_[q]; c2 += kd4[q] * r_[q]; } \
                c1 = allsum16(c1); c2 = allsum16(c2); \
                const float vv = __uint_as_float((unsigned)vr[e] << 16); \
                u32x4 kkwr, kkakd; kkwr.x = pk_f16(q_[0], q_[1]); kkwr.y = pk_f16(q_[2], q_[3]); kkwr.z = pk_f16(wr4[0], wr4[1]); kkwr.w = pk_f16(wr4[2], wr4[3]); \
                kkakd.x = pk_f16(kka4[0], kka4[1]); kkakd.y = pk_f16(kka4[2], kka4[3]); kkakd.z = pk_f16(kd4[0], kd4[1]); kkakd.w = pk_f16(kd4[2], kd4[3]); \
                *(LAS f32x4*)(bp + 16 * kq) = w4; *(LAS u32x4*)(bp + 256 + 16 * kq) = kkwr; *(LAS u32x4*)(bp + 512 + 16 * kq) = kkakd; \
                *(LAS f32x4*)(bp + 768 + 16 * kq) = (f32x4){vv, vv * c2 * 0.0625f, c1 * 0.0625f, 0.f}; } } while (0)
            SC_LOAD(0); SC_CONV(0); SC_LOAD(1);
            SCAN_BAR();
            for (int c = 0; c < SC_NCH; ++c) {
                if (c + 1 < SC_NCH) { SC_CONV((c + 1) & 1); }
                if (c + 2 < SC_NCH) { SC_LOAD(c + 2); }
                SCAN_BAR();
            }
#undef SC_LOAD
#undef SC_CONV
        } else {
            const int j = lane & 15, rr_ = lane >> 4, row = rg * 16 + wid * 4 + rr_;
            float st[4] = {0.f, 0.f, 0.f, 0.f};
            float pacc[16];
            const unsigned lbase = (unsigned)(size_t)lds;
            const long ystep = dir ? -512 : 512;
            SCAN_BAR();
            for (int c = 0; c < SC_NCH; ++c) {
                const unsigned cb = lbase + (c & 1) * SC_BUF;
                const unsigned bp = cb + 16 * j, vp = cb + 768 + 16 * (wid * 4 + rr_);
                const int sg = c * SC_CH + j; const int t = dir ? (T_ - 1 - sg) : sg;
                bf16_t* const yrow = YSg + (tokbase + t) * 512 + ch0 + row;
                ScanOps A, B;
                scan_ld<0>(A, bp, vp);
                scan_pair<0>(st, pacc, A, B, bp, vp, j, yrow, ystep);
                asm volatile("" : "+v"(st[0]), "+v"(st[1]), "+v"(st[2]), "+v"(st[3]));
                SCAN_BAR();
            }
        }
    }
}

__device__ __forceinline__ void combine_phase(const Params& p, const int tid) {
    const int lane = tid & 63, wid = tid >> 6;
    const int gw = blockIdx.x * 8 + wid, nw = gridDim.x * 8;
    unsigned char* ws = p.ws;
    const int c0 = lane * 8;
    const bf16_t* Y0 = (const bf16_t*)(ws + WS_YS0); const bf16_t* Y1 = (const bf16_t*)(ws + WS_YS1);
    const bf16_t* Rg = (const bf16_t*)(ws + WS_R); const bf16_t* Kg = (const bf16_t*)(ws + WS_K); const bf16_t* Vg = (const bf16_t*)(ws + WS_V);
    const bf16_t* A0 = (const bf16_t*)(ws + WS_OUT5 + 2 * SZ_TOK512); const bf16_t* A1 = (const bf16_t*)(ws + WS_OUT5 + 3 * SZ_TOK512); const bf16_t* Gg = (const bf16_t*)(ws + WS_OUT5 + 4 * SZ_TOK512);
    bf16_t* YM = (bf16_t*)(ws + WS_YMIX);
    float gnw[8], gnb[8], rk[8], ka[8];
#pragma unroll
    for (int q = 0; q < 8; ++q) { gnw[q] = p.in[21][c0 + q]; gnb[q] = p.in[22][c0 + q]; rk[q] = p.in[20][c0 + q]; ka[q] = p.in[19][c0 + q]; }
    u32x4 cur[8], nxt[8];
#define CMB_LOAD(dst, tk) do { const size_t o_ = (size_t)(tk) * 512 + c0; dst[0] = *(const u32x4*)(Y0 + o_); dst[1] = *(const u32x4*)(Y1 + o_); dst[2] = *(const u32x4*)(Rg + o_); dst[3] = *(const u32x4*)(Kg + o_); \
        dst[4] = *(const u32x4*)(Vg + o_); dst[5] = *(const u32x4*)(Gg + o_); dst[6] = *(const u32x4*)(A0 + o_); dst[7] = *(const u32x4*)(A1 + o_); } while (0)
    if (gw < M_) CMB_LOAD(cur, gw);
    for (int tok = gw; tok < M_; tok += nw) {
        if (tok + nw < M_) CMB_LOAD(nxt, tok + nw);
        float y0[8], y1[8], r[8], k[8], v[8], a0[8], a1[8], g[8];
        unpack8_bf(cur[0], y0); unpack8_bf(cur[1], y1); unpack8_bf(cur[2], r); unpack8_bf(cur[3], k); unpack8_bf(cur[4], v); unpack8_bf(cur[5], g);
        unpack8_h(cur[6], a0); unpack8_h(cur[7], a1);
        float y[8], s = 0.f, bs = 0.f;
#pragma unroll
        for (int q = 0; q < 8; ++q) { y[q] = y0[q] + y1[q]; s += y[q]; bs += r[q] * k[q] * rk[q] * (2.0f + (a0[q] + a1[q] - 2.0f) * ka[q]); }
        s = sum8(s); bs = sum8(bs);
        const float mean = s * (1.0f / 64.0f);
        float qv = 0.f;
#pragma unroll
        for (int q = 0; q < 8; ++q) { y[q] -= mean; qv += y[q] * y[q]; }
        qv = sum8(qv);
        const float rstd = __builtin_amdgcn_rsqf(qv * (1.0f / 64.0f) + 64e-5f);
        float o8[8];
#pragma unroll
        for (int q = 0; q < 8; ++q) o8[q] = ((y[q] * rstd) * gnw[q] + gnb[q] + bs * v[q]) * g[q];
        *(u32x4*)(YM + (size_t)tok * 1024 + 512 + c0) = pack8_bf(o8);
#pragma unroll
        for (int q = 0; q < 8; ++q) cur[q] = nxt[q];
    }
#undef CMB_LOAD
}

#define XB_TMO      128
#define XB_XCNT(j)  (256  + 64 * (j))
#define XB_XSUB(j)  (1280 + 64 * (j))
#define XB_XGEN(j)  (2304 + 64 * (j))
#define XB_TOP      3328
#define XB_TOPGEN   3392
#define XCD_BAR_WORDS 3456
#define XB_SPIN_CAP (1u << 18)

__device__ __forceinline__ unsigned xb_ld(unsigned* p)              { return __hip_atomic_load(p, __ATOMIC_RELAXED, __HIP_MEMORY_SCOPE_AGENT); }
__device__ __forceinline__ unsigned xb_add(unsigned* p, unsigned v) { return __hip_atomic_fetch_add(p, v, __ATOMIC_RELAXED, __HIP_MEMORY_SCOPE_AGENT); }
__device__ __forceinline__ unsigned xb_xcc_id() { return (unsigned)__builtin_amdgcn_s_getreg((3 << 11) | 20) & 0xFu; }
#define XB_SPIN(cond, bar) do { unsigned _sp = 0; while (cond) { __builtin_amdgcn_s_sleep(1); \
    if ((++_sp & 255u) == 0u) { if (xb_ld(&(bar)[XB_TMO])) break; if (_sp > XB_SPIN_CAP) { atomicAdd(&(bar)[XB_TMO], 1u); break; } } } } while (0)

struct XcdBarrier {
    unsigned* bar; unsigned x;
    volatile LAS unsigned* st;
};

__device__ __forceinline__ XcdBarrier xcd_barrier_post(unsigned* bar, volatile LAS unsigned* st) {
    XcdBarrier b; b.bar = bar; b.x = xb_xcc_id(); b.st = st;
    if (threadIdx.x == 0) (void)xb_add(&bar[XB_XCNT(b.x)], 1u);
    return b;
}
__device__ __forceinline__ void xcd_barrier_complete(unsigned* bar, unsigned x, unsigned& nloc, unsigned& nx) {
    const unsigned G = gridDim.x * gridDim.y * gridDim.z;
    unsigned sum, cnt, mine, sp = 0u;
    for (;;) {
        sum = 0u; cnt = 0u; mine = 0u;
#pragma unroll
        for (unsigned j = 0; j < 16; ++j) { const unsigned c = xb_ld(&bar[XB_XCNT(j)]); sum += c; cnt += (c > 0u) ? 1u : 0u; mine = (j == x) ? c : mine; }
        if (sum == G) break;
        __builtin_amdgcn_s_sleep(1);
        if ((++sp & 255u) == 0u) { if (xb_ld(&bar[XB_TMO])) break; if (sp > XB_SPIN_CAP) { atomicAdd(&bar[XB_TMO], 1u); break; } }
    }
    nloc = mine > 0u ? mine : 1u; nx = cnt > 0u ? cnt : 1u;
}

__device__ __forceinline__ void xcd_barrier(const XcdBarrier& b) {
    asm volatile("s_waitcnt vmcnt(0)" ::: "memory");
    __syncthreads();
    if (threadIdx.x == 0) {
        unsigned* bar = b.bar;
        __builtin_amdgcn_s_waitcnt(0);
        unsigned nloc = b.st[0], nx = b.st[1];
        if (nloc == 0u) { xcd_barrier_complete(bar, b.x, nloc, nx); b.st[0] = nloc; b.st[1] = nx; }
        const unsigned old = xb_add(&bar[XB_XSUB(b.x)], 1u);
        const unsigned gen = old / nloc;
        if (old + 1u == (gen + 1u) * nloc) {
            __builtin_amdgcn_fence(__ATOMIC_RELEASE, "agent");
            asm volatile("s_waitcnt vmcnt(0)" ::: "memory");
            const unsigned og = xb_add(&bar[XB_TOP], 1u);
            const unsigned tg = og / nx;
            if (og + 1u == (tg + 1u) * nx) xb_add(&bar[XB_TOPGEN], 1u);
            else XB_SPIN(xb_ld(&bar[XB_TOPGEN]) == tg, bar);
            __builtin_amdgcn_fence(__ATOMIC_ACQUIRE, "agent");
            xb_add(&bar[XB_XGEN(b.x)], 1u);
            asm volatile("s_waitcnt vmcnt(0)" ::: "memory");
        } else {
            XB_SPIN(xb_ld(&bar[XB_XGEN(b.x)]) == gen, bar);
            __builtin_amdgcn_fence(__ATOMIC_ACQUIRE, "agent");
            asm volatile("s_waitcnt vmcnt(0)" ::: "memory");
        }
    }
    __syncthreads();
}

#ifndef PROBE_MASK
#define PROBE_MASK 0
#endif
__global__ void __launch_bounds__(NTHREADS, 2) fwd_kernel(Params p) {
    extern __shared__ __attribute__((aligned(16))) unsigned char lds_raw[];
    LAS unsigned char* lds = (LAS unsigned char*)lds_raw;
    unsigned char* ws = p.ws;
    float* mod = (float*)(ws + WS_MOD); float* fmod = (float*)(ws + WS_FMOD);
    bf16_t* H = (bf16_t*)(ws + WS_H);
    if (threadIdx.x < 4) ((LAS unsigned*)(lds + 131072))[threadIdx.x] = 0u;
    __syncthreads();
    XcdBarrier bar; bar.bar = (unsigned*)(ws + WS_BAR); bar.x = 0; bar.st = (volatile LAS unsigned*)(lds + 131072);
    if (p.coop) bar = xcd_barrier_post((unsigned*)(ws + WS_BAR), (volatile LAS unsigned*)(lds + 131072));
    for (int ph = p.ph_lo; ph < p.ph_hi; ++ph) {
        for (int rep = 0; rep < (((PROBE_MASK >> ph) & 1) ? 2 : 1); ++rep) {
        if (rep) __syncthreads();
        int tid = threadIdx.x; asm volatile("" : "+v"(tid));
        switch (ph) {
            case 0: p0_prologue(p, lds, tid); break;
            case 1: modulate_phase<false>(p.in[0], p.in[4], mod + 0, mod + 1024, 9216, H, nullptr, tid); break;
            case 4: modulate_phase<false>(p.out, p.in[8], mod + 3072, mod + 4096, 9216, H, nullptr, tid); break;
            case 12: modulate_phase<false>(p.out, p.in[24], mod + 6144, mod + 7168, 9216, H, nullptr, tid); break;
            case 15: modulate_phase<true>(p.out, p.in[30], fmod + 0, fmod + 1024, 2048, nullptr, p.out, tid, H, mod + 8192); break;
            case 7: prep_phase(p, tid); break;
            case 9: scan_phase(p, lds, tid); break;
            case 10: combine_phase(p, tid); break;
            default: {
                pg8::Gemm g; pg8::EpiGen E;
                E.mode = 0; E.O = nullptr; E.ldo = 0; E.base = nullptr; E.out = nullptr; E.gate = nullptr; E.gscale = 1.f; E.w0 = p.in[13]; E.a0 = p.in[15];
                g.M = M_;
                switch (ph) {
                    case 2: g.A = H; g.Bt = (const bf16_t*)(ws + WS_WGU1); g.N = 5632; g.K = 1024; E.mode = 1; E.O = (bf16_t*)(ws + WS_HID); E.ldo = 2816; break;
                    case 3: g.A = (const bf16_t*)(ws + WS_HID); g.Bt = (const bf16_t*)(ws + WS_WD1); g.N = 1024; g.K = 2816; E.mode = 2; E.base = p.in[0]; E.out = p.out; E.gate = mod + 2048; E.gscale = 0.5f; break;
                    case 5: g.A = H; g.Bt = (const bf16_t*)(ws + WS_WINC); g.N = 1536; g.K = 1024; E.mode = 0; E.O = (bf16_t*)(ws + WS_PROJC); E.ldo = 1536; break;
                    case 6: g.A = H; g.Bt = (const bf16_t*)(ws + WS_WINR); g.N = 1792; g.K = 1024; E.mode = 0; E.O = (bf16_t*)(ws + WS_PROJR); E.ldo = 1792; break;
                    case 8: g.A = (const bf16_t*)(ws + WS_AP); g.Bt = (const bf16_t*)(ws + WS_WLORA); g.N = 2560; g.K = 256; E.mode = 3; E.O = (bf16_t*)(ws + WS_OUT5); E.ldo = 512; break;
                    case 11: g.A = (const bf16_t*)(ws + WS_YMIX); g.Bt = (const bf16_t*)(ws + WS_WOUT); g.N = 1024; g.K = 1024; E.mode = 2; E.base = p.out; E.out = p.out; E.gate = mod + 5120; E.gscale = 1.0f; break;
                    case 13: g.A = H; g.Bt = (const bf16_t*)(ws + WS_WGU2); g.N = 5632; g.K = 1024; E.mode = 1; E.O = (bf16_t*)(ws + WS_HID); E.ldo = 2816; break;
                    default: g.A = (const bf16_t*)(ws + WS_HID); g.Bt = (const bf16_t*)(ws + WS_WD2); g.N = 1024; g.K = 2816; E.mode = 0; E.O = H; E.ldo = 1024; break;
                }
                pg8::StaticOrder S; S.init(g.M, g.N, (int)gridDim.x, (int)blockIdx.x);
                pg8::gemm_phase<pg8::EpiGen, pg8::StaticOrder>(lds, g, S, E, tid);
            } break;
        }
        }
        if (ph + 1 < p.ph_hi) {
            if (ph == 5) __syncthreads();
            else if (p.pad != 0) cg::this_grid().sync();
            else xcd_barrier(bar);
        }
    }
}

constexpr int N_PHASES = 16;
#ifndef ONE_LAUNCH
#define ONE_LAUNCH 1
#endif
extern "C" void kernel_launch(void* const* d_in, const int* in_sizes, int n_in, void* d_out, int out_size, void* d_ws, size_t ws_size, hipStream_t stream) {
    static int grid = 0;
    if (grid == 0) {
        int dev = 0, cus = 0, per_cu = 0;
        hipGetDevice(&dev);
        hipDeviceGetAttribute(&cus, hipDeviceAttributeMultiprocessorCount, dev);
        hipFuncSetAttribute((const void*)fwd_kernel, hipFuncAttributeMaxDynamicSharedMemorySize, LDS_BYTES);
        hipOccupancyMaxActiveBlocksPerMultiprocessor(&per_cu, (const void*)fwd_kernel, NTHREADS, LDS_BYTES);
        if (per_cu < 1) per_cu = 1;
        grid = cus * 1;
        if (grid <= 0) grid = 256;
        if (ws_size < WS_END) fprintf(stderr, "kernel_launch: workspace too small: %zu < %zu\n", ws_size, (size_t)WS_END);
        if (n_in != 31) fprintf(stderr, "kernel_launch: expected 31 inputs, got %d\n", n_in);
        (void)hipGetLastError();
    }
    Params p{};
    for (int i = 0; i < 31; ++i) p.in[i] = (const float*)d_in[i];
    p.out = (float*)d_out; p.ws = (unsigned char*)d_ws; p.pad = 0;
#if ONE_LAUNCH
    (void)hipMemsetAsync((char*)d_ws + WS_BAR, 0, 16384, stream);
    p.ph_lo = 0; p.ph_hi = N_PHASES; p.coop = 1;
    void* args[] = {&p};
    hipError_t e = hipLaunchCooperativeKernel((const void*)fwd_kernel, dim3(grid), dim3(NTHREADS), args, LDS_BYTES, stream);
    if (e != hipSuccess) fprintf(stderr, "cooperative launch failed: %s (grid %d)\n", hipGetErrorString(e), grid);
#else
    p.coop = 0;
    for (int ph = 0; ph < N_PHASES; ++ph) {
        p.ph_lo = ph; p.ph_hi = ph + 1;
        hipLaunchKernelGGL(fwd_kernel, dim3(grid), dim3(NTHREADS), LDS_BYTES, stream, p);
    }
#endif
}
```

```cpp
#include <hip/hip_runtime.h>
#include <hip/hip_cooperative_groups.h>
#include <cstdio>
namespace cg = cooperative_groups;
namespace pg8 {
#define PG8_LAS __attribute__((address_space(3)))
typedef unsigned short bf16_t;
typedef short bf16x8 __attribute__((ext_vector_type(8)));
typedef float f32x4 __attribute__((ext_vector_type(4)));
typedef unsigned u32x4 __attribute__((ext_vector_type(4)));
constexpr int BM = 256, BK = 64, HALF = 128, HTB = HALF * BK * 2  , STAGE_BYTES = 8 * HTB, NXCD = 8, WGM = 8;

__host__ __device__ __forceinline__ int lds_byte(int r, int c) { const int st = (r >> 4) * 2 + (c >> 5), rr = r & 15, cc = c & 31, ob = rr * 64 + cc * 2; return st * 1024 + (ob ^ (((ob >> 9) & 1) << 5)); }
__host__ __device__ __forceinline__ void stage_rc(int b, int& R, int& C) { const int st = b / 1024, sb = b % 1024, swz = sb ^ (((sb >> 9) & 1) << 5); R = (st >> 1) * 16 + swz / 64; C = (st & 1) * 32 + (swz % 64) / 2; }
__host__ __device__ __forceinline__ int perm32(int rho) { const int n = rho >> 4, i = rho & 15; return 8 * (i >> 2) + 4 * n + (i & 3); }

struct Unit { int pm, pn; };
struct Gemm { const bf16_t* A; const bf16_t* Bt; int M, N, K; };

struct StaticOrder {
    int nM, nN, nwg, G, c;
    __host__ __device__ void init(int M, int N, int G_, int c_) { nM = M / BM; nN = N / BM; nwg = nM * nN; G = G_; c = c_; }
    __host__ __device__ bool next(int i, Unit& u) const {
        const long L = (long)i * G + c; if (L >= nwg) return false;
        int wgid = (int)L; { const int q = nwg / NXCD, r = nwg % NXCD, xcd = wgid % NXCD, off = wgid / NXCD; wgid = (xcd < r ? xcd * (q + 1) : r * (q + 1) + (xcd - r) * q) + off; }
        const int nig = WGM * nN, gid = wgid / nig, fm = gid * WGM, gsz = (nM - fm) < WGM ? (nM - fm) : WGM;
        u.pm = fm + ((wgid % nig) % gsz); u.pn = (wgid % nig) / gsz; return true;
    }
    __device__ __forceinline__ void a_ready(const Unit&) const {}
    __device__ __forceinline__ void done(const Unit&) const {}
};
__device__ __forceinline__ unsigned cvt_pk_bf16(float lo, float hi) { unsigned r; asm volatile("v_cvt_pk_bf16_f32 %0, %1, %2" : "=v"(r) : "v"(lo), "v"(hi)); return r; }
template <class Epi, class Sched>
__device__ __forceinline__ void gemm_phase(PG8_LAS unsigned char* lds, const Gemm g, const Sched& S, const Epi& E, const int tid) {
    const int wid = __builtin_amdgcn_readfirstlane(tid >> 6), lane = tid & 63, wr = wid >> 2, wc = wid & 3, fr = lane & 15, fq = lane >> 4;
    const int K = g.K, nt = K / BK;
    unsigned voffA[2], voffB[2];
#pragma unroll
    for (int i = 0; i < 2; ++i) { int R, C; stage_rc(tid * 16 + i * 8192, R, C); const int Rb = Epi::PERM ? ((R & ~31) + perm32(R & 31)) : R;
        voffA[i] = (unsigned)(R * K + C) * 2u; voffB[i] = (unsigned)(Rb * K + C) * 2u; }
    const size_t kstep = (size_t)(BK * 2);
    const size_t hstep = (size_t)HALF * K * 2;
    const size_t tstep = 2 * hstep;
    const unsigned ldsw = (unsigned)wid * 1024u;
    const int aoff = lds_byte(wr * 64 + fr, fq * 8), boff = lds_byte(wc * 32 + fr, fq * 8);
#define PG8_SA(b, h) (((b) * 2 + (h)) * HTB)
#define PG8_SB(b, h) ((4 + (b) * 2 + (h)) * HTB)
#define PG8_STAGE(bufoff, gbase, voff) do { _Pragma("unroll") for (int _i = 0; _i < 2; ++_i) \
        __builtin_amdgcn_global_load_lds((const unsigned*)((const char*)(gbase) + (voff)[_i]), (PG8_LAS unsigned*)(lds + (bufoff) + ldsw + _i * 8192), 16, 0, 0); } while (0)
#define PG8_LDA(dst, b, h) do { _Pragma("unroll") for (int m = 0; m < 4; ++m) _Pragma("unroll") for (int k = 0; k < 2; ++k) dst[m][k] = *(const PG8_LAS bf16x8*)(lds + PG8_SA(b, h) + aoff + m * 2048 + k * 1024); } while (0)
#define PG8_LDB(dst, b, h) do { _Pragma("unroll") for (int n = 0; n < 2; ++n) _Pragma("unroll") for (int k = 0; k < 2; ++k) dst[n][k] = *(const PG8_LAS bf16x8*)(lds + PG8_SB(b, h) + boff + n * 2048 + k * 1024); } while (0)
#define PG8_MMA(ai, bj, At, Bt) do { __builtin_amdgcn_s_setprio(1); _Pragma("unroll") for (int m = 0; m < 4; ++m) _Pragma("unroll") for (int n = 0; n < 2; ++n) _Pragma("unroll") for (int k = 0; k < 2; ++k) \
        acc[ai][bj][m][n] = __builtin_amdgcn_mfma_f32_16x16x32_bf16(Bt[n][k], At[m][k], acc[ai][bj][m][n], 0, 0, 0); __builtin_amdgcn_s_setprio(0); } while (0)
#define PG8_WAIT_V(n) asm volatile("s_waitcnt vmcnt(" #n ")" ::: "memory")
#define PG8_WAIT_L(n) asm volatile("s_waitcnt lgkmcnt(" #n ")" ::: "memory")
#define PG8_BAR __builtin_amdgcn_s_barrier()
#define PG8_SCHED __builtin_amdgcn_sched_barrier(0)
    Unit cur, nxt; int ui = 0;
    if (!S.next(0, cur)) return;
    f32x4 acc[2][2][4][2];
#pragma unroll
    for (int a = 0; a < 2; ++a)
#pragma unroll
        for (int b = 0; b < 2; ++b)
#pragma unroll
            for (int m = 0; m < 4; ++m)
#pragma unroll
                for (int n = 0; n < 2; ++n) acc[a][b][m][n] = (f32x4){0.f, 0.f, 0.f, 0.f};
    bf16x8 At[4][2], B0[2][2], B1[2][2];
    const char* cA = (const char*)g.A + (size_t)cur.pm * tstep; const char* cB = (const char*)g.Bt + (size_t)cur.pn * tstep;
    S.a_ready(cur);
    PG8_STAGE(PG8_SB(0, 0), cB, voffB); PG8_STAGE(PG8_SA(0, 0), cA, voffA); PG8_STAGE(PG8_SB(0, 1), cB + hstep, voffB); PG8_STAGE(PG8_SA(0, 1), cA + hstep, voffA);
    if (wr == 1) PG8_BAR;
    PG8_WAIT_V(4); PG8_BAR;
    PG8_STAGE(PG8_SB(1, 0), cB + kstep, voffB); PG8_STAGE(PG8_SA(1, 0), cA + kstep, voffA); PG8_STAGE(PG8_SB(1, 1), cB + hstep + kstep, voffB);
    PG8_WAIT_V(6); PG8_BAR;
    for (;;) {
        const bool has_next = S.next(ui + 1, nxt);
        const char* nA = has_next ? (const char*)g.A + (size_t)nxt.pm * tstep : cA; const char* nB = has_next ? (const char*)g.Bt + (size_t)nxt.pn * tstep : cB;
        for (int t = 0; t < nt; t += 2) {
            const bool last = (t == nt - 2);
            const char* a1 = cA + (size_t)(t + 1) * kstep;
            const char* a2 = last ? nA : cA + (size_t)(t + 2) * kstep; const char* b2 = last ? nB : cB + (size_t)(t + 2) * kstep;
            const char* a3 = a2 + kstep; const char* b3 = b2 + kstep;
            if (last && has_next) S.a_ready(nxt);
            PG8_LDB(B0, 0, 0); PG8_SCHED; PG8_LDA(At, 0, 0); PG8_STAGE(PG8_SA(1, 1), a1 + hstep, voffA);
            PG8_WAIT_L(8); PG8_BAR; PG8_WAIT_L(0); PG8_MMA(0, 0, At, B0); PG8_BAR; PG8_SCHED;
            PG8_LDB(B1, 0, 1); PG8_STAGE(PG8_SB(0, 0), b2, voffB);
            PG8_BAR; PG8_WAIT_L(0); PG8_MMA(0, 1, At, B1); PG8_BAR;
            PG8_LDA(At, 0, 1); PG8_STAGE(PG8_SA(0, 0), a2, voffA);
            PG8_BAR; PG8_WAIT_L(0); PG8_MMA(1, 0, At, B0); PG8_BAR; PG8_SCHED;
            PG8_STAGE(PG8_SB(0, 1), b2 + hstep, voffB);
            PG8_WAIT_V(6); PG8_BAR; PG8_MMA(1, 1, At, B1); PG8_BAR;
            PG8_LDB(B0, 1, 0); PG8_SCHED; PG8_LDA(At, 1, 0); PG8_STAGE(PG8_SA(0, 1), a2 + hstep, voffA);
            PG8_WAIT_L(8); PG8_BAR; PG8_WAIT_L(0); PG8_MMA(0, 0, At, B0); PG8_BAR; PG8_SCHED;
            PG8_LDB(B1, 1, 1); PG8_STAGE(PG8_SB(1, 0), b3, voffB);
            PG8_BAR; PG8_WAIT_L(0); PG8_MMA(0, 1, At, B1); PG8_BAR;
            PG8_LDA(At, 1, 1); PG8_STAGE(PG8_SA(1, 0), a3, voffA);
            PG8_BAR; PG8_WAIT_L(0); PG8_MMA(1, 0, At, B0); PG8_BAR; PG8_SCHED;
            PG8_STAGE(PG8_SB(1, 1), b3 + hstep, voffB);
            PG8_WAIT_V(6); PG8_BAR; PG8_MMA(1, 1, At, B1); PG8_BAR;
        }
        if constexpr (!Epi::AFTER_DRAIN) { E(acc, cur, wr, wc, fr, fq); S.done(cur); }
        if (!has_next) break;
#pragma unroll
        for (int a = 0; a < 2; ++a)
#pragma unroll
            for (int b = 0; b < 2; ++b)
#pragma unroll
                for (int m = 0; m < 4; ++m)
#pragma unroll
                    for (int n = 0; n < 2; ++n) acc[a][b][m][n] = (f32x4){0.f, 0.f, 0.f, 0.f};
        cur = nxt; cA = nA; cB = nB; ++ui;
    }
    PG8_WAIT_V(0);
    if (wr == 0) PG8_BAR;
    PG8_BAR;
    if constexpr (Epi::AFTER_DRAIN) { E.fused(acc, cur, wr, wc, fr, fq, lds, wid, lane); S.done(cur); }
#undef PG8_SA
#undef PG8_SB
#undef PG8_STAGE
#undef PG8_LDA
#undef PG8_LDB
#undef PG8_MMA
#undef PG8_WAIT_V
#undef PG8_WAIT_L
#undef PG8_BAR
#undef PG8_SCHED
}
}

#define LAS __attribute__((address_space(3)))
typedef unsigned short bf16_t;
typedef float f32x4 __attribute__((ext_vector_type(4)));
typedef unsigned u32x4 __attribute__((ext_vector_type(4)));
typedef unsigned u32x2 __attribute__((ext_vector_type(2)));
constexpr int M_ = 32768, D_ = 1024, F_ = 2816, T_ = 8192;
constexpr int NTHREADS = 512;
constexpr int LDS_BYTES = 131072 + 16;
constexpr size_t SZ_TOK512 = (size_t)M_ * 512 * 2;
constexpr size_t WS_BAR = 0;
constexpr size_t WS_MOD = 16384;
constexpr size_t WS_FMOD = WS_MOD + 4 * 9216 * 4;
constexpr size_t WS_WGU1 = WS_FMOD + 4 * 2048 * 4;
constexpr size_t WS_WD1 = WS_WGU1 + (size_t)5632 * 1024 * 2;
constexpr size_t WS_WGU2 = WS_WD1 + (size_t)1024 * 2816 * 2;
constexpr size_t WS_WD2 = WS_WGU2 + (size_t)5632 * 1024 * 2;
constexpr size_t WS_WINC = WS_WD2 + (size_t)1024 * 2816 * 2;
constexpr size_t WS_WINR = WS_WINC + (size_t)1536 * 1024 * 2;
constexpr size_t WS_WLORA = WS_WINR + (size_t)1792 * 1024 * 2;
constexpr size_t WS_WOUT = WS_WLORA + (size_t)2560 * 256 * 2;
constexpr size_t WS_H = WS_WOUT + (size_t)1024 * 1024 * 2;
constexpr size_t WS_YMIX = WS_H + (size_t)M_ * 1024 * 2;
constexpr size_t WS_BIG = WS_YMIX + (size_t)M_ * 1024 * 2;
constexpr size_t WS_EXTRA = WS_BIG + (size_t)M_ * 3328 * 2;
constexpr size_t WS_END = WS_EXTRA + 3 * SZ_TOK512 + (size_t)M_ * 256 * 2;
constexpr size_t WS_HID = WS_BIG;
constexpr size_t WS_PROJC = WS_BIG;
constexpr size_t WS_PROJR = WS_BIG + (size_t)M_ * 1536 * 2;
constexpr size_t WS_OUT5 = WS_BIG;
constexpr size_t WS_YS1 = WS_BIG + 5 * SZ_TOK512;
constexpr size_t WS_R = WS_H;
constexpr size_t WS_K = WS_H + SZ_TOK512;
constexpr size_t WS_V = WS_EXTRA;
constexpr size_t WS_KK = WS_EXTRA + SZ_TOK512;
constexpr size_t WS_AP = WS_EXTRA + 2 * SZ_TOK512;
constexpr size_t WS_YS0 = WS_AP + (size_t)M_ * 256 * 2;
static_assert(WS_END <= 536870912ull, "workspace");

struct Params {
    const float* in[31];
    float* out; unsigned char* ws;
    int ph_lo, ph_hi, coop, pad;
};

__device__ __forceinline__ float sigm(float x) { return __builtin_amdgcn_rcpf(1.0f + __builtin_amdgcn_exp2f(-1.44269504f * x)); }
__device__ __forceinline__ unsigned pk_bf16(float lo, float hi) { return pg8::cvt_pk_bf16(lo, hi); }
__device__ __forceinline__ unsigned pk_f16(float lo, float hi) { typedef _Float16 h2 __attribute__((ext_vector_type(2))); h2 v; v.x = (_Float16)lo; v.y = (_Float16)hi; return __builtin_bit_cast(unsigned, v); }
__device__ __forceinline__ float bf_lo(unsigned w) { return __uint_as_float(w << 16); }
__device__ __forceinline__ float bf_hi(unsigned w) { return __uint_as_float(w & 0xffff0000u); }
__device__ __forceinline__ float h_lo(unsigned w) { typedef _Float16 h2 __attribute__((ext_vector_type(2))); h2 v = __builtin_bit_cast(h2, w); return (float)v.x; }
__device__ __forceinline__ float h_hi(unsigned w) { typedef _Float16 h2 __attribute__((ext_vector_type(2))); h2 v = __builtin_bit_cast(h2, w); return (float)v.y; }
__device__ __forceinline__ void unpack8_bf(const u32x4 w, float (&f)[8]) { f[0] = bf_lo(w.x); f[1] = bf_hi(w.x); f[2] = bf_lo(w.y); f[3] = bf_hi(w.y); f[4] = bf_lo(w.z); f[5] = bf_hi(w.z); f[6] = bf_lo(w.w); f[7] = bf_hi(w.w); }
__device__ __forceinline__ void unpack8_h(const u32x4 w, float (&f)[8]) { f[0] = h_lo(w.x); f[1] = h_hi(w.x); f[2] = h_lo(w.y); f[3] = h_hi(w.y); f[4] = h_lo(w.z); f[5] = h_hi(w.z); f[6] = h_lo(w.w); f[7] = h_hi(w.w); }
__device__ __forceinline__ u32x4 pack8_bf(const float (&f)[8]) { u32x4 w; w.x = pk_bf16(f[0], f[1]); w.y = pk_bf16(f[2], f[3]); w.z = pk_bf16(f[4], f[5]); w.w = pk_bf16(f[6], f[7]); return w; }
__device__ __forceinline__ void load8_bf(const bf16_t* p, float (&f)[8]) { unpack8_bf(*(const u32x4*)p, f); }

namespace pg8 {
struct EpiGen {
    static constexpr bool PERM = true, AFTER_DRAIN = false;
    int mode;
    bf16_t* O; int ldo;
    const float* base; float* out; const float* gate; float gscale;
    const float* w0; const float* a0;
    __device__ __forceinline__ void operator()(const f32x4 (&acc)[2][2][4][2], const Unit& u, int wr, int wc, int fr, int fq) const {
        const int row0 = u.pm * BM + wr * 64 + fr;
        if (mode == 1) {
            const int col0 = u.pn * 128 + wc * 32 + 8 * fq;
#pragma unroll
            for (int ai = 0; ai < 2; ++ai)
#pragma unroll
                for (int m = 0; m < 4; ++m) {
                    const f32x4 g0 = acc[ai][0][m][0], g1 = acc[ai][0][m][1], u0 = acc[ai][1][m][0], u1 = acc[ai][1][m][1];
                    float h[8];
#pragma unroll
                    for (int j = 0; j < 4; ++j) { h[j] = g0[j] * sigm(g0[j]) * u0[j]; h[4 + j] = g1[j] * sigm(g1[j]) * u1[j]; }
                    *(u32x4*)(O + (size_t)(row0 + ai * HALF + m * 16) * ldo + col0) = pack8_bf(h);
                }
        } else if (mode == 0) {
            const int col0 = u.pn * BM + wc * 32 + 8 * fq;
#pragma unroll
            for (int ai = 0; ai < 2; ++ai)
#pragma unroll
                for (int m = 0; m < 4; ++m)
#pragma unroll
                    for (int bj = 0; bj < 2; ++bj) {
                        const f32x4 v0 = acc[ai][bj][m][0], v1 = acc[ai][bj][m][1];
                        u32x4 w; w.x = cvt_pk_bf16(v0[0], v0[1]); w.y = cvt_pk_bf16(v0[2], v0[3]); w.z = cvt_pk_bf16(v1[0], v1[1]); w.w = cvt_pk_bf16(v1[2], v1[3]);
                        *(u32x4*)(O + (size_t)(row0 + ai * HALF + m * 16) * ldo + col0 + bj * HALF) = w;
                    }
        } else if (mode == 2) {
            const int b = u.pm >> 5;
            const int col0 = u.pn * BM + wc * 32 + 8 * fq;
            f32x4 gv[2][2];
#pragma unroll
            for (int bj = 0; bj < 2; ++bj)
#pragma unroll
                for (int n = 0; n < 2; ++n) gv[bj][n] = *(const f32x4*)(gate + (size_t)b * 9216 + col0 + bj * HALF + 4 * n) * gscale;
            f32x4 bs[3][2][2];
#define RES_LOAD(it) do { const size_t off_ = (size_t)(row0 + ((it) >> 2) * HALF + ((it) & 3) * 16) * 1024 + col0; \
                _Pragma("unroll") for (int bj = 0; bj < 2; ++bj) _Pragma("unroll") for (int n = 0; n < 2; ++n) bs[(it) % 3][bj][n] = *(const f32x4*)(base + off_ + bj * HALF + 4 * n); } while (0)
            RES_LOAD(0); RES_LOAD(1);
#pragma unroll
            for (int it = 0; it < 8; ++it) {
                if (it + 2 < 8) RES_LOAD(it + 2);
                const size_t off = (size_t)(row0 + (it >> 2) * HALF + (it & 3) * 16) * 1024 + col0;
#pragma unroll
                for (int bj = 0; bj < 2; ++bj)
#pragma unroll
                    for (int n = 0; n < 2; ++n) *(f32x4*)(out + off + bj * HALF + 4 * n) = bs[it % 3][bj][n] + gv[bj][n] * acc[it >> 2][bj][it & 3][n];
            }
#undef RES_LOAD
        } else {
            const int arr = u.pn >> 1;
            const int colt = (u.pn & 1) * 256 + wc * 32 + 8 * fq;
            bf16_t* Ob = O + (size_t)arr * ((size_t)32768 * 512);
            f32x4 bv[2][2];
#pragma unroll
            for (int bj = 0; bj < 2; ++bj)
#pragma unroll
                for (int n = 0; n < 2; ++n) {
                    const int c = colt + bj * HALF + 4 * n;
                    bv[bj][n] = arr < 2 ? *(const f32x4*)(w0 + arr * 512 + c) : (arr < 4 ? *(const f32x4*)(a0 + (arr - 2) * 512 + c) : (f32x4){0.f, 0.f, 0.f, 0.f});
                }
#pragma unroll
            for (int ai = 0; ai < 2; ++ai)
#pragma unroll
                for (int m = 0; m < 4; ++m)
#pragma unroll
                    for (int bj = 0; bj < 2; ++bj) {
                        f32x4 v0 = acc[ai][bj][m][0] + bv[bj][0], v1 = acc[ai][bj][m][1] + bv[bj][1];
                        u32x4 w;
                        if (arr < 4) {
                            const float sc = arr < 2 ? 0.87503877f : 1.0f;
#pragma unroll
                            for (int j = 0; j < 4; ++j) { v0[j] = sc * sigm(v0[j]); v1[j] = sc * sigm(v1[j]); }
                            w.x = pk_f16(v0[0], v0[1]); w.y = pk_f16(v0[2], v0[3]); w.z = pk_f16(v1[0], v1[1]); w.w = pk_f16(v1[2], v1[3]);
                        } else {
                            w.x = cvt_pk_bf16(v0[0], v0[1]); w.y = cvt_pk_bf16(v0[2], v0[3]); w.z = cvt_pk_bf16(v1[0], v1[1]); w.w = cvt_pk_bf16(v1[2], v1[3]);
                        }
                        *(u32x4*)(Ob + (size_t)(row0 + ai * HALF + m * 16) * 512 + colt + bj * HALF) = w;
                    }
        }
    }
};
}

__device__ __forceinline__ float wave_sum64(float v) {
#pragma unroll
    for (int o = 32; o >= 1; o >>= 1) v += __shfl_xor(v, o);
    return v;
}
__device__ __forceinline__ float sum8(float v) { v += __shfl_xor(v, 1); v += __shfl_xor(v, 2); v += __shfl_xor(v, 4); return v; }

__device__ __forceinline__ void p0_prologue(const Params& p, LAS unsigned char* lds, const int tid) {
    unsigned char* ws = p.ws;
    LAS float* sc = (LAS float*)lds;
    LAS float* red = (LAS float*)(lds + 16384);
    {
        const float* c = p.in[1];
        for (int i = tid; i < 4096; i += NTHREADS) { const float v = c[i]; sc[i] = v * sigm(v); }
    }
    __syncthreads();
    for (int cb = blockIdx.x; cb < 176; cb += gridDim.x) {
        const int cc = tid & 63, dg = tid >> 6, col = cb * 64 + cc;
        const float* W; const float* bias; float* dst; int ld, jc;
        if (col < 9216) { W = p.in[2]; bias = p.in[3]; dst = (float*)(ws + WS_MOD); ld = 9216; jc = col; }
        else { W = p.in[28]; bias = p.in[29]; dst = (float*)(ws + WS_FMOD); ld = 2048; jc = col - 9216; }
        float a0 = 0.f, a1 = 0.f, a2 = 0.f, a3 = 0.f;
        const float* wp = W + (size_t)(dg * 128) * ld + jc;
#pragma unroll 32
        for (int d = 0; d < 128; ++d) {
            const float w = wp[(size_t)d * ld]; const int dd = dg * 128 + d;
            a0 += sc[dd] * w; a1 += sc[1024 + dd] * w; a2 += sc[2048 + dd] * w; a3 += sc[3072 + dd] * w;
        }
        red[(dg * 64 + cc) * 4 + 0] = a0; red[(dg * 64 + cc) * 4 + 1] = a1; red[(dg * 64 + cc) * 4 + 2] = a2; red[(dg * 64 + cc) * 4 + 3] = a3;
        __syncthreads();
        if (tid < 256) {
            const int b = tid >> 6, c2 = tid & 63;
            float s = 0.f;
#pragma unroll
            for (int g = 0; g < 8; ++g) s += red[(g * 64 + c2) * 4 + b];
            const int col2 = cb * 64 + c2; const int jc2 = col2 < 9216 ? col2 : col2 - 9216;
            dst[(size_t)b * ld + jc2] = s + bias[jc2];
        }
        __syncthreads();
    }
    LAS float* tile = (LAS float*)(lds + 32768);
    for (int ti = blockIdx.x; ti < 5312; ti += gridDim.x) {
        int job, r;
        if (ti < 4224) { job = ti / 704; r = ti % 704; } else if (ti < 5056) { job = 6; r = ti - 4224; } else { job = 7; r = ti - 5056; }
        const float* W; int K, N;
        switch (job) {
            case 0: W = p.in[5]; K = 1024; N = 2816; break;
            case 1: W = p.in[6]; K = 1024; N = 2816; break;
            case 2: W = p.in[7]; K = 2816; N = 1024; break;
            case 3: W = p.in[25]; K = 1024; N = 2816; break;
            case 4: W = p.in[26]; K = 1024; N = 2816; break;
            case 5: W = p.in[27]; K = 2816; N = 1024; break;
            case 6: W = p.in[9]; K = 1024; N = 3328; break;
            default: W = p.in[23]; K = 1024; N = 1024; break;
        }
        const int nkt = K / 64, kt = r % nkt, ntile = r / nkt;
        {
            const int c = tid & 63, r0 = tid >> 6;
#pragma unroll
            for (int i = 0; i < 8; ++i) { const int kr = i * 8 + r0; tile[kr * 65 + c] = W[(size_t)(kt * 64 + kr) * N + ntile * 64 + c]; }
        }
        __syncthreads();
        {
            const int nl = tid >> 3, k8 = (tid & 7) * 8, n = ntile * 64 + nl;
            bf16_t* dst; int row;
            switch (job) {
                case 0: dst = (bf16_t*)(ws + WS_WGU1); row = 256 * (n >> 7) + (n & 127); break;
                case 1: dst = (bf16_t*)(ws + WS_WGU1); row = 256 * (n >> 7) + 128 + (n & 127); break;
                case 2: dst = (bf16_t*)(ws + WS_WD1); row = n; break;
                case 3: dst = (bf16_t*)(ws + WS_WGU2); row = 256 * (n >> 7) + (n & 127); break;
                case 4: dst = (bf16_t*)(ws + WS_WGU2); row = 256 * (n >> 7) + 128 + (n & 127); break;
                case 5: dst = (bf16_t*)(ws + WS_WD2); row = n; break;
                case 6: if (n < 1536) { dst = (bf16_t*)(ws + WS_WINC); row = n; } else { dst = (bf16_t*)(ws + WS_WINR); row = n - 1536; } break;
                default: dst = (bf16_t*)(ws + WS_WOUT); row = n; break;
            }
            float f[8];
#pragma unroll
            for (int q = 0; q < 8; ++q) f[q] = tile[(k8 + q) * 65 + nl];
            *(u32x4*)(dst + (size_t)row * K + kt * 64 + k8) = pack8_bf(f);
        }
        __syncthreads();
    }
    {
        bf16_t* WL = (bf16_t*)(ws + WS_WLORA);
        const float* w_up = p.in[14]; const float* a_up = p.in[16]; const float* g_up = p.in[17];
        for (int idx = blockIdx.x * NTHREADS + tid; idx < 2560 * 256; idx += gridDim.x * NTHREADS) {
            const int n = idx % 2560, k = idx / 2560;
            float val = 0.f;
            if (n < 1024) { const int d = n >> 9, c = n & 511; if (k < 64) val = w_up[(size_t)(d * 64 + k) * 512 + c]; }
            else if (n < 2048) { const int n2 = n - 1024, d = n2 >> 9, c = n2 & 511; if (k >= 64 && k < 128) val = a_up[(size_t)(d * 64 + k - 64) * 512 + c]; }
            else { const int c = n - 2048; if (k >= 128) val = g_up[(size_t)(k - 128) * 512 + c]; }
            WL[(size_t)n * 256 + k] = (bf16_t)(pk_bf16(val, val) & 0xffffu);
        }
    }
}

template <bool FINAL>
__device__ __forceinline__ void modulate_phase(const float* X, const float* gvec, const float* shift, const float* scale, int mod_ld, bf16_t* outH, float* outF, const int tid,
                                               const bf16_t* delta = nullptr, const float* dgate = nullptr) {
    const int lane = tid & 63, wid = tid >> 6;
    const int gw = blockIdx.x * 8 + wid, nw = gridDim.x * 8;
    f32x4 g4[4];
#pragma unroll
    for (int i = 0; i < 4; ++i) g4[i] = *(const f32x4*)(gvec + i * 256 + lane * 4);
    f32x4 x4[4], xn[4];
    if (gw < M_) {
#pragma unroll
        for (int i = 0; i < 4; ++i) x4[i] = *(const f32x4*)(X + (size_t)gw * 1024 + i * 256 + lane * 4);
    }
    for (int row = gw; row < M_; row += nw) {
        const int b = row >> 13;
        f32x4 sc4[4], sh4[4], gt[4]; u32x2 dw[4];
#pragma unroll
        for (int i = 0; i < 4; ++i) {
            sc4[i] = *(const f32x4*)(scale + (size_t)b * mod_ld + i * 256 + lane * 4);
            sh4[i] = *(const f32x4*)(shift + (size_t)b * mod_ld + i * 256 + lane * 4);
            if (FINAL) { dw[i] = *(const u32x2*)(delta + (size_t)row * 1024 + i * 256 + lane * 4); gt[i] = *(const f32x4*)(dgate + (size_t)b * 9216 + i * 256 + lane * 4); }
        }
        const int nrow = row + nw;
        if (nrow < M_) {
#pragma unroll
            for (int i = 0; i < 4; ++i) xn[i] = *(const f32x4*)(X + (size_t)nrow * 1024 + i * 256 + lane * 4);
        }
        float ss = 0.f;
#pragma unroll
        for (int i = 0; i < 4; ++i) {
            if (FINAL) x4[i] += (gt[i] * 0.5f) * (f32x4){bf_lo(dw[i].x), bf_hi(dw[i].x), bf_lo(dw[i].y), bf_hi(dw[i].y)};
            ss += x4[i][0] * x4[i][0] + x4[i][1] * x4[i][1] + x4[i][2] * x4[i][2] + x4[i][3] * x4[i][3];
        }
        ss = wave_sum64(ss);
        const float rstd = __builtin_amdgcn_rsqf(ss * (1.0f / 1024.0f) + 1e-6f);
#pragma unroll
        for (int i = 0; i < 4; ++i) {
            const f32x4 y = (x4[i] * rstd) * g4[i] * (sc4[i] + 1.0f) + sh4[i];
            if (FINAL) *(f32x4*)(outF + (size_t)row * 1024 + i * 256 + lane * 4) = y;
            else { u32x2 w; w.x = pk_bf16(y[0], y[1]); w.y = pk_bf16(y[2], y[3]); *(u32x2*)(outH + (size_t)row * 1024 + i * 256 + lane * 4) = w; }
        }
#pragma unroll
        for (int i = 0; i < 4; ++i) x4[i] = xn[i];
    }
}

__device__ __forceinline__ void prep_phase(const Params& p, const int tid) {
    const int lane = tid & 63, wid = tid >> 6;
    const int gw = blockIdx.x * 8 + wid, nw = gridDim.x * 8;
    unsigned char* ws = p.ws;
    const int c0 = lane * 8;
    {
        const bf16_t* PC = (const bf16_t*)(ws + WS_PROJC);
        bf16_t* YM = (bf16_t*)(ws + WS_YMIX);
        float cw0[8], cw1[8], cw2[8], cbv[8];
#pragma unroll
        for (int q = 0; q < 8; ++q) { cw0[q] = p.in[10][c0 + q]; cw1[q] = p.in[10][512 + c0 + q]; cw2[q] = p.in[10][1024 + c0 + q]; cbv[q] = p.in[11][c0 + q]; }
        for (int task = gw; task < M_ / 16; task += nw) {
            const int t0 = task * 16, tl0 = t0 & (T_ - 1);
            float up[8], uc[8], un[8], a[8], b[8];
            if (tl0 == 0) {
#pragma unroll
                for (int q = 0; q < 8; ++q) up[q] = 0.f;
            } else {
                load8_bf(PC + (size_t)(t0 - 1) * 1536 + 512 + c0, a); load8_bf(PC + (size_t)(t0 - 1) * 1536 + 1024 + c0, b);
#pragma unroll
                for (int q = 0; q < 8; ++q) up[q] = a[q] * b[q];
            }
            load8_bf(PC + (size_t)t0 * 1536 + 512 + c0, a); load8_bf(PC + (size_t)t0 * 1536 + 1024 + c0, b);
#pragma unroll
            for (int q = 0; q < 8; ++q) uc[q] = a[q] * b[q];
            for (int i = 0; i < 16; ++i) {
                const int tok = t0 + i;
                if (tl0 + i + 1 < T_) {
                    load8_bf(PC + (size_t)(tok + 1) * 1536 + 512 + c0, a); load8_bf(PC + (size_t)(tok + 1) * 1536 + 1024 + c0, b);
#pragma unroll
                    for (int q = 0; q < 8; ++q) un[q] = a[q] * b[q];
                } else {
#pragma unroll
                    for (int q = 0; q < 8; ++q) un[q] = 0.f;
                }
                float cbr[8], y[8];
                load8_bf(PC + (size_t)tok * 1536 + c0, cbr);
#pragma unroll
                for (int q = 0; q < 8; ++q) y[q] = cbr[q] * (cw0[q] * up[q] + cw1[q] * uc[q] + cw2[q] * un[q] + cbv[q]);
                *(u32x4*)(YM + (size_t)tok * 1024 + c0) = pack8_bf(y);
#pragma unroll
                for (int q = 0; q < 8; ++q) { up[q] = uc[q]; uc[q] = un[q]; }
            }
        }
    }
    {
        const bf16_t* PR = (const bf16_t*)(ws + WS_PROJR);
        bf16_t* Ro = (bf16_t*)(ws + WS_R); bf16_t* Ko = (bf16_t*)(ws + WS_K); bf16_t* Vo = (bf16_t*)(ws + WS_V); bf16_t* KKo = (bf16_t*)(ws + WS_KK); bf16_t* APo = (bf16_t*)(ws + WS_AP);
        const float* mu = p.in[12]; const float* k_k = p.in[18];
        float mur[8], muk[8], muv[8], mus[4], kkw[8];
#pragma unroll
        for (int q = 0; q < 8; ++q) { mur[q] = mu[c0 + q]; muk[q] = mu[512 + c0 + q]; muv[q] = mu[1024 + c0 + q]; kkw[q] = k_k[c0 + q]; }
#pragma unroll
        for (int q = 0; q < 4; ++q) mus[q] = mu[1536 + lane * 4 + q];
        for (int task = gw; task < M_ / 16; task += nw) {
            const int t0 = task * 16, tl0 = t0 & (T_ - 1);
            float pr[8], pk[8], pv[8], ps[4], cr[8], ck[8], cv[8], cs[4], nr[8], nk[8], nv[8], ns[4];
            if (tl0 == 0) {
#pragma unroll
                for (int q = 0; q < 8; ++q) { pr[q] = 0.f; pk[q] = 0.f; pv[q] = 0.f; }
#pragma unroll
                for (int q = 0; q < 4; ++q) ps[q] = 0.f;
            } else {
                const bf16_t* b = PR + (size_t)(t0 - 1) * 1792;
                load8_bf(b + c0, pr); load8_bf(b + 512 + c0, pk); load8_bf(b + 1024 + c0, pv);
                const u32x2 w = *(const u32x2*)(b + 1536 + lane * 4); ps[0] = bf_lo(w.x); ps[1] = bf_hi(w.x); ps[2] = bf_lo(w.y); ps[3] = bf_hi(w.y);
            }
            {
                const bf16_t* b = PR + (size_t)t0 * 1792;
                load8_bf(b + c0, cr); load8_bf(b + 512 + c0, ck); load8_bf(b + 1024 + c0, cv);
                const u32x2 w = *(const u32x2*)(b + 1536 + lane * 4); cs[0] = bf_lo(w.x); cs[1] = bf_hi(w.x); cs[2] = bf_lo(w.y); cs[3] = bf_hi(w.y);
            }
            for (int i = 0; i < 16; ++i) {
                const int tok = t0 + i;
                if (tl0 + i + 1 < T_) {
                    const bf16_t* b = PR + (size_t)(tok + 1) * 1792;
                    load8_bf(b + c0, nr); load8_bf(b + 512 + c0, nk); load8_bf(b + 1024 + c0, nv);
                    const u32x2 w = *(const u32x2*)(b + 1536 + lane * 4); ns[0] = bf_lo(w.x); ns[1] = bf_hi(w.x); ns[2] = bf_lo(w.y); ns[3] = bf_hi(w.y);
                } else {
#pragma unroll
                    for (int q = 0; q < 8; ++q) { nr[q] = 0.f; nk[q] = 0.f; nv[q] = 0.f; }
#pragma unroll
                    for (int q = 0; q < 4; ++q) ns[q] = 0.f;
                }
                float rs[8], ks[8], vs[8], kkv[8], ss = 0.f;
#pragma unroll
                for (int q = 0; q < 8; ++q) {
                    rs[q] = cr[q] + mur[q] * (0.5f * (pr[q] + nr[q]) - cr[q]);
                    ks[q] = ck[q] + muk[q] * (0.5f * (pk[q] + nk[q]) - ck[q]);
                    vs[q] = cv[q] + muv[q] * (0.5f * (pv[q] + nv[q]) - cv[q]);
                    kkv[q] = ks[q] * kkw[q]; ss += kkv[q] * kkv[q];
                }
                ss = sum8(ss);
                const float rn = __builtin_amdgcn_rsqf(ss + 1e-12f);
#pragma unroll
                for (int q = 0; q < 8; ++q) kkv[q] *= rn;
                *(u32x4*)(Ro + (size_t)tok * 512 + c0) = pack8_bf(rs);
                *(u32x4*)(Ko + (size_t)tok * 512 + c0) = pack8_bf(ks);
                *(u32x4*)(Vo + (size_t)tok * 512 + c0) = pack8_bf(vs);
                *(u32x4*)(KKo + (size_t)tok * 512 + c0) = pack8_bf(kkv);
                float sv[4];
#pragma unroll
                for (int q = 0; q < 4; ++q) {
                    const float s = cs[q] + mus[q] * (0.5f * (ps[q] + ns[q]) - cs[q]);
                    const float th = 2.0f * sigm(2.0f * s) - 1.0f, sg = sigm(s);
                    sv[q] = lane < 16 ? th : (lane < 32 ? s : sg);
                }
                { u32x2 w; w.x = pk_bf16(sv[0], sv[1]); w.y = pk_bf16(sv[2], sv[3]); *(u32x2*)(APo + (size_t)tok * 256 + lane * 4) = w; }
#pragma unroll
                for (int q = 0; q < 8; ++q) { pr[q] = cr[q]; pk[q] = ck[q]; pv[q] = cv[q]; cr[q] = nr[q]; ck[q] = nk[q]; cv[q] = nv[q]; }
#pragma unroll
                for (int q = 0; q < 4; ++q) { ps[q] = cs[q]; cs[q] = ns[q]; }
            }
        }
    }
}

typedef float f32x2 __attribute__((ext_vector_type(2)));
template <int CTRL> __device__ __forceinline__ float dpp_add(float x) { return x + __int_as_float(__builtin_amdgcn_update_dpp(0, __float_as_int(x), CTRL, 0xf, 0xf, false)); }
__device__ __forceinline__ float allsum16(float x) { x = dpp_add<0x121>(x); x = dpp_add<0x122>(x); x = dpp_add<0x124>(x); x = dpp_add<0x128>(x); return x; }
#define SCAN_BAR() asm volatile("s_waitcnt lgkmcnt(0)\n\ts_barrier" ::: "memory")
constexpr int SC_STEP = 1024, SC_CH = 64, SC_BUF = SC_STEP * SC_CH, SC_NCH = T_ / SC_CH;
typedef _Float16 h8 __attribute__((ext_vector_type(8)));
struct ScanOps { f32x4 W; u32x4 KKWR, KKAKD; f32x4 VC; };
template <int S> __device__ __forceinline__ void scan_ld(ScanOps& o, const unsigned bp, const unsigned vp) {
    asm volatile("ds_read_b128 %0, %1 offset:%2" : "=v"(o.KKWR) : "v"(bp), "n"(S * SC_STEP + 256));
    asm volatile("ds_read_b128 %0, %1 offset:%2" : "=v"(o.VC) : "v"(vp), "n"(S * SC_STEP));
    asm volatile("ds_read_b128 %0, %1 offset:%2" : "=v"(o.W) : "v"(bp), "n"(S * SC_STEP));
    asm volatile("ds_read_b128 %0, %1 offset:%2" : "=v"(o.KKAKD) : "v"(bp), "n"(S * SC_STEP + 512));
}
template <int N> __device__ __forceinline__ void scan_wait(ScanOps& o) {
    asm volatile("s_waitcnt lgkmcnt(%4)" : "+v"(o.W), "+v"(o.KKWR), "+v"(o.KKAKD), "+v"(o.VC) : "n"(N));
}
__device__ __forceinline__ float scan_step(float (&st)[4], const ScanOps& o) {
    const h8 a = __builtin_bit_cast(h8, o.KKWR), b = __builtin_bit_cast(h8, o.KKAKD);
    const float v = o.VC[0];
    float pa = __builtin_fmaf(st[0], (float)a[0], o.VC[3]); pa = __builtin_fmaf(st[1], (float)a[1], pa); pa = __builtin_fmaf(st[2], (float)a[2], pa);
    float pb = __builtin_fmaf(st[0], (float)a[4], o.VC[1]); pb = __builtin_fmaf(st[1], (float)a[5], pb); pb = __builtin_fmaf(st[2], (float)a[6], pb);
    float sa = __builtin_fmaf(st[3], (float)a[3], pa);
    const float pp = __builtin_fmaf(st[3], (float)a[7], pb);
    const float m0 = st[0] * o.W[0], m1 = st[1] * o.W[1];
    sa = dpp_add<0x121>(sa);
    const float m2 = st[2] * o.W[2], m3 = st[3] * o.W[3];
    sa = dpp_add<0x122>(sa);
    const float t0 = __builtin_fmaf((float)b[4], v, m0), t1 = __builtin_fmaf((float)b[5], v, m1);
    sa = dpp_add<0x124>(sa);
    const float t2 = __builtin_fmaf((float)b[6], v, m2), t3 = __builtin_fmaf((float)b[7], v, m3);
    sa = dpp_add<0x128>(sa);
    st[0] = __builtin_fmaf(-(float)b[0], sa, t0); st[1] = __builtin_fmaf(-(float)b[1], sa, t1); st[2] = __builtin_fmaf(-(float)b[2], sa, t2); st[3] = __builtin_fmaf(-(float)b[3], sa, t3);
    return __builtin_fmaf(-sa, o.VC[2], pp);
}
template <int CTRL> __device__ __forceinline__ float dpp_mov(float x) { return __int_as_float(__builtin_amdgcn_update_dpp(0, __float_as_int(x), CTRL, 0xf, 0xf, false)); }
__device__ __forceinline__ float transpose_reduce16(float (&p)[16], const int j) {
#define TRA1(h, l) "v_add_f32_dpp %" #h ", %" #h ", %" #h " row_ror:8 row_mask:0xf bank_mask:0xc\n\tv_add_f32_dpp %" #h ", %" #l ", %" #l " row_ror:8 row_mask:0xf bank_mask:0x3\n\t"
    asm volatile(TRA1(0, 8) TRA1(1, 9) TRA1(2, 10) TRA1(3, 11) TRA1(4, 12) TRA1(5, 13) TRA1(6, 14) TRA1(7, 15)
                 : "+v"(p[8]), "+v"(p[9]), "+v"(p[10]), "+v"(p[11]), "+v"(p[12]), "+v"(p[13]), "+v"(p[14]), "+v"(p[15])
                 : "v"(p[0]), "v"(p[1]), "v"(p[2]), "v"(p[3]), "v"(p[4]), "v"(p[5]), "v"(p[6]), "v"(p[7]));
#undef TRA1
#define TRB1(h, l) "v_add_f32_dpp %" #h ", %" #h ", %" #h " row_ror:4 row_mask:0xf bank_mask:0xa\n\tv_add_f32_dpp %" #h ", %" #l ", %" #l " row_ror:12 row_mask:0xf bank_mask:0x5\n\t"
    asm volatile(TRB1(0, 4) TRB1(1, 5) TRB1(2, 6) TRB1(3, 7)
                 : "+v"(p[12]), "+v"(p[13]), "+v"(p[14]), "+v"(p[15]) : "v"(p[8]), "v"(p[9]), "v"(p[10]), "v"(p[11]));
#undef TRB1
    const bool b1 = (j & 2) != 0, b0 = (j & 1) != 0;
    float q0, q1;
    { const float keep = b1 ? p[14] : p[12], send = b1 ? p[12] : p[14]; q0 = keep + dpp_mov<0x4E>(send); }
    { const float keep = b1 ? p[15] : p[13], send = b1 ? p[13] : p[15]; q1 = keep + dpp_mov<0x4E>(send); }
    const float keep = b0 ? q1 : q0, send = b0 ? q0 : q1;
    return keep + dpp_mov<0xB1>(send);
}
template <int S> __device__ __forceinline__ void scan_pair(float (&st)[4], float (&pacc)[16], ScanOps& A, ScanOps& B, const unsigned bp, const unsigned vp, const int j,
                                                          bf16_t* const yrow, const long ystep) {
    scan_ld<S + 1>(B, bp, vp);
    scan_wait<4>(A);
    pacc[S & 15] = scan_step(st, A);
    if constexpr (S + 2 < SC_CH) { scan_ld<S + 2>(A, bp, vp); scan_wait<4>(B); } else { scan_wait<0>(B); }
    pacc[(S + 1) & 15] = scan_step(st, B);
    if constexpr (((S + 2) & 15) == 0) {
        const float y = transpose_reduce16(pacc, j);
        yrow[(long)((S + 2) / 16 - 1) * 16 * ystep] = (bf16_t)(pk_bf16(y, y) & 0xffffu);
    }
    if constexpr (S + 2 < SC_CH) scan_pair<S + 2>(st, pacc, A, B, bp, vp, j, yrow, ystep);
}

__device__ __forceinline__ void scan_phase(const Params& p, LAS unsigned char* lds, const int tid) {
    const int lane = tid & 63, wid = __builtin_amdgcn_readfirstlane(tid >> 6);
    unsigned char* ws = p.ws;
    const bf16_t* Rg = (const bf16_t*)(ws + WS_R); const bf16_t* Kg = (const bf16_t*)(ws + WS_K); const bf16_t* Vg = (const bf16_t*)(ws + WS_V); const bf16_t* KKg = (const bf16_t*)(ws + WS_KK);
    for (int unit = blockIdx.x; unit < 256; unit += gridDim.x) {
        const int xcd = unit & 7, jj = unit >> 3, seq = xcd * 8 + (jj >> 2), rg = jj & 3;
        const int dir = seq >> 5, b = (seq >> 3) & 3, h = seq & 7;
        const size_t tokbase = (size_t)b * T_; const int ch0 = h * 64;
        const bf16_t* DWg = (const bf16_t*)(ws + WS_OUT5 + (size_t)dir * SZ_TOK512);
        const bf16_t* AAg = (const bf16_t*)(ws + WS_OUT5 + (size_t)(2 + dir) * SZ_TOK512);
        bf16_t* YSg = (bf16_t*)(ws + (dir ? WS_YS1 : WS_YS0));
        if (wid >= 4) {
            const int pt = tid - 256, sl = pt >> 4, kq = pt & 15;
            float ka4[4];
#pragma unroll
            for (int q = 0; q < 4; ++q) ka4[q] = p.in[19][ch0 + 4 * kq + q];
            u32x2 rr[4], kr[4], kkr[4], ar[4], dr[4]; unsigned short vr[4];
#define SC_LOAD(c) do { _Pragma("unroll") for (int e = 0; e < 4; ++e) { const int s = (c) * SC_CH + sl + 16 * e; const int t = dir ? (T_ - 1 - s) : s; \
                const size_t o = (tokbase + t) * 512 + ch0 + 4 * kq; \
                rr[e] = *(const u32x2*)(Rg + o); kr[e] = *(const u32x2*)(Kg + o); kkr[e] = *(const u32x2*)(KKg + o); ar[e] = *(const u32x2*)(AAg + o); dr[e] = *(const u32x2*)(DWg + o); \
                vr[e] = Vg[(tokbase + t) * 512 + ch0 + rg * 16 + kq]; } } while (0)
#define SC_CONV(bufi) do { _Pragma("unroll") for (int e = 0; e < 4; ++e) { LAS unsigned char* bp = lds + (bufi) * SC_BUF + (sl + 16 * e) * SC_STEP; \
                const float r_[4] = {bf_lo(rr[e].x), bf_hi(rr[e].x), bf_lo(rr[e].y), bf_hi(rr[e].y)}; \
                const float k_[4] = {bf_lo(kr[e].x), bf_hi(kr[e].x), bf_lo(kr[e].y), bf_hi(kr[e].y)}; \
                const float q_[4] = {bf_lo(kkr[e].x), bf_hi(kkr[e].x), bf_lo(kkr[e].y), bf_hi(kkr[e].y)}; \
                const float a_[4] = {h_lo(ar[e].x), h_hi(ar[e].x), h_lo(ar[e].y), h_hi(ar[e].y)}; \
                const float d_[4] = {h_lo(dr[e].x), h_hi(dr[e].x), h_lo(dr[e].y), h_hi(dr[e].y)}; \
                f32x4 w4; float kka4[4], kd4[4], wr4[4]; float c1 = 0.f, c2 = 0.f; \
                _Pragma("unroll") for (int q = 0; q < 4; ++q) { w4[q] = __builtin_amdgcn_exp2f(-d_[q]); kka4[q] = q_[q] * a_[q]; kd4[q] = k_[q] * (1.0f + (a_[q] - 1.0f) * ka4[q]); wr4[q] = w4[q] * r_[q]; \
                    c1 += kka4[q] * r_[q]; c2 += kd4[q] * r_[q]; } \
                c1 = allsum16(c1); c2 = allsum16(c2); \
                const float vv = __uint_as_float((unsigned)vr[e] << 16); \
                u32x4 kkwr, kkakd; kkwr.x = pk_f16(q_[0], q_[1]); kkwr.y = pk_f16(q_[2], q_[3]); kkwr.z = pk_f16(wr4[0], wr4[1]); kkwr.w = pk_f16(wr4[2], wr4[3]); \
                kkakd.x = pk_f16(kka4[0], kka4[1]); kkakd.y = pk_f16(kka4[2], kka4[3]); kkakd.z = pk_f16(kd4[0], kd4[1]); kkakd.w = pk_f16(kd4[2], kd4[3]); \
                *(LAS f32x4*)(bp + 16 * kq) = w4; *(LAS u32x4*)(bp + 256 + 16 * kq) = kkwr; *(LAS u32x4*)(bp + 512 + 16 * kq) = kkakd; \
                *(LAS f32x4*)(bp + 768 + 16 * kq) = (f32x4){vv, vv * c2 * 0.0625f, c1 * 0.0625f, 0.f}; } } while (0)
            SC_LOAD(0); SC_CONV(0); SC_LOAD(1);
            SCAN_BAR();
            for (int c = 0; c < SC_NCH; ++c) {
                if (c + 1 < SC_NCH) { SC_CONV((c + 1) & 1); }
                if (c + 2 < SC_NCH) { SC_LOAD(c + 2); }
                SCAN_BAR();
            }
#undef SC_LOAD
#undef SC_CONV
        } else {
            const int j = lane & 15, rr_ = lane >> 4, row = rg * 16 + wid * 4 + rr_;
            float st[4] = {0.f, 0.f, 0.f, 0.f};
            float pacc[16];
            const unsigned lbase = (unsigned)(size_t)lds;
            const long ystep = dir ? -512 : 512;
            SCAN_BAR();
            for (int c = 0; c < SC_NCH; ++c) {
                const unsigned cb = lbase + (c & 1) * SC_BUF;
                const unsigned bp = cb + 16 * j, vp = cb + 768 + 16 * (wid * 4 + rr_);
                const int sg = c * SC_CH + j; const int t = dir ? (T_ - 1 - sg) : sg;
                bf16_t* const yrow = YSg + (tokbase + t) * 512 + ch0 + row;
                ScanOps A, B;
                scan_ld<0>(A, bp, vp);
                scan_pair<0>(st, pacc, A, B, bp, vp, j, yrow, ystep);
                asm volatile("" : "+v"(st[0]), "+v"(st[1]), "+v"(st[2]), "+v"(st[3]));
                SCAN_BAR();
            }
        }
    }
}

__device__ __forceinline__ void combine_phase(const Params& p, const int tid) {
    const int lane = tid & 63, wid = tid >> 6;
    const int gw = blockIdx.x * 8 + wid, nw = gridDim.x * 8;
    unsigned char* ws = p.ws;
    const int c0 = lane * 8;
    const bf16_t* Y0 = (const bf16_t*)(ws + WS_YS0); const bf16_t* Y1 = (const bf16_t*)(ws + WS_YS1);
    const bf16_t* Rg = (const bf16_t*)(ws + WS_R); const bf16_t* Kg = (const bf16_t*)(ws + WS_K); const bf16_t* Vg = (const bf16_t*)(ws + WS_V);
    const bf16_t* A0 = (const bf16_t*)(ws + WS_OUT5 + 2 * SZ_TOK512); const bf16_t* A1 = (const bf16_t*)(ws + WS_OUT5 + 3 * SZ_TOK512); const bf16_t* Gg = (const bf16_t*)(ws + WS_OUT5 + 4 * SZ_TOK512);
    bf16_t* YM = (bf16_t*)(ws + WS_YMIX);
    float gnw[8], gnb[8], rk[8], ka[8];
#pragma unroll
    for (int q = 0; q < 8; ++q) { gnw[q] = p.in[21][c0 + q]; gnb[q] = p.in[22][c0 + q]; rk[q] = p.in[20][c0 + q]; ka[q] = p.in[19][c0 + q]; }
    u32x4 cur[8], nxt[8];
#define CMB_LOAD(dst, tk) do { const size_t o_ = (size_t)(tk) * 512 + c0; dst[0] = *(const u32x4*)(Y0 + o_); dst[1] = *(const u32x4*)(Y1 + o_); dst[2] = *(const u32x4*)(Rg + o_); dst[3] = *(const u32x4*)(Kg + o_); \
        dst[4] = *(const u32x4*)(Vg + o_); dst[5] = *(const u32x4*)(Gg + o_); dst[6] = *(const u32x4*)(A0 + o_); dst[7] = *(const u32x4*)(A1 + o_); } while (0)
    if (gw < M_) CMB_LOAD(cur, gw);
    for (int tok = gw; tok < M_; tok += nw) {
        if (tok + nw < M_) CMB_LOAD(nxt, tok + nw);
        float y0[8], y1[8], r[8], k[8], v[8], a0[8], a1[8], g[8];
        unpack8_bf(cur[0], y0); unpack8_bf(cur[1], y1); unpack8_bf(cur[2], r); unpack8_bf(cur[3], k); unpack8_bf(cur[4], v); unpack8_bf(cur[5], g);
        unpack8_h(cur[6], a0); unpack8_h(cur[7], a1);
        float y[8], s = 0.f, bs = 0.f;
#pragma unroll
        for (int q = 0; q < 8; ++q) { y[q] = y0[q] + y1[q]; s += y[q]; bs += r[q] * k[q] * rk[q] * (2.0f + (a0[q] + a1[q] - 2.0f) * ka[q]); }
        s = sum8(s); bs = sum8(bs);
        const float mean = s * (1.0f / 64.0f);
        float qv = 0.f;
#pragma unroll
        for (int q = 0; q < 8; ++q) { y[q] -= mean; qv += y[q] * y[q]; }
        qv = sum8(qv);
        const float rstd = __builtin_amdgcn_rsqf(qv * (1.0f / 64.0f) + 64e-5f);
        float o8[8];
#pragma unroll
        for (int q = 0; q < 8; ++q) o8[q] = ((y[q] * rstd) * gnw[q] + gnb[q] + bs * v[q]) * g[q];
        *(u32x4*)(YM + (size_t)tok * 1024 + 512 + c0) = pack8_bf(o8);
#pragma unroll
        for (int q = 0; q < 8; ++q) cur[q] = nxt[q];
    }
#undef CMB_LOAD
}

#define XB_TMO      128
#define XB_XCNT(j)  (256  + 64 * (j))
#define XB_XSUB(j)  (1280 + 64 * (j))
#define XB_XGEN(j)  (2304 + 64 * (j))
#define XB_TOP      3328
#define XB_TOPGEN   3392
#define XCD_BAR_WORDS 3456
#define XB_SPIN_CAP (1u << 18)

__device__ __forceinline__ unsigned xb_ld(unsigned* p)              { return __hip_atomic_load(p, __ATOMIC_RELAXED, __HIP_MEMORY_SCOPE_AGENT); }
__device__ __forceinline__ unsigned xb_add(unsigned* p, unsigned v) { return __hip_atomic_fetch_add(p, v, __ATOMIC_RELAXED, __HIP_MEMORY_SCOPE_AGENT); }
__device__ __forceinline__ unsigned xb_xcc_id() { return (unsigned)__builtin_amdgcn_s_getreg((3 << 11) | 20) & 0xFu; }
#define XB_SPIN(cond, bar) do { unsigned _sp = 0; while (cond) { __builtin_amdgcn_s_sleep(1); \
    if ((++_sp & 255u) == 0u) { if (xb_ld(&(bar)[XB_TMO])) break; if (_sp > XB_SPIN_CAP) { atomicAdd(&(bar)[XB_TMO], 1u); break; } } } } while (0)

struct XcdBarrier {
    unsigned* bar; unsigned x;
    volatile LAS unsigned* st;
};

__device__ __forceinline__ XcdBarrier xcd_barrier_post(unsigned* bar, volatile LAS unsigned* st) {
    XcdBarrier b; b.bar = bar; b.x = xb_xcc_id(); b.st = st;
    if (threadIdx.x == 0) (void)xb_add(&bar[XB_XCNT(b.x)], 1u);
    return b;
}
__device__ __forceinline__ void xcd_barrier_complete(unsigned* bar, unsigned x, unsigned& nloc, unsigned& nx) {
    const unsigned G = gridDim.x * gridDim.y * gridDim.z;
    unsigned sum, cnt, mine, sp = 0u;
    for (;;) {
        sum = 0u; cnt = 0u; mine = 0u;
#pragma unroll
        for (unsigned j = 0; j < 16; ++j) { const unsigned c = xb_ld(&bar[XB_XCNT(j)]); sum += c; cnt += (c > 0u) ? 1u : 0u; mine = (j == x) ? c : mine; }
        if (sum == G) break;
        __builtin_amdgcn_s_sleep(1);
        if ((++sp & 255u) == 0u) { if (xb_ld(&bar[XB_TMO])) break; if (sp > XB_SPIN_CAP) { atomicAdd(&bar[XB_TMO], 1u); break; } }
    }
    nloc = mine > 0u ? mine : 1u; nx = cnt > 0u ? cnt : 1u;
}

__device__ __forceinline__ void xcd_barrier(const XcdBarrier& b) {
    asm volatile("s_waitcnt vmcnt(0)" ::: "memory");
    __syncthreads();
    if (threadIdx.x == 0) {
        unsigned* bar = b.bar;
        __builtin_amdgcn_s_waitcnt(0);
        unsigned nloc = b.st[0], nx = b.st[1];
        if (nloc == 0u) { xcd_barrier_complete(bar, b.x, nloc, nx); b.st[0] = nloc; b.st[1] = nx; }
        const unsigned old = xb_add(&bar[XB_XSUB(b.x)], 1u);
        const unsigned gen = old / nloc;
        if (old + 1u == (gen + 1u) * nloc) {
            __builtin_amdgcn_fence(__ATOMIC_RELEASE, "agent");
            asm volatile("s_waitcnt vmcnt(0)" ::: "memory");
            const unsigned og = xb_add(&bar[XB_TOP], 1u);
            const unsigned tg = og / nx;
            if (og + 1u == (tg + 1u) * nx) xb_add(&bar[XB_TOPGEN], 1u);
            else XB_SPIN(xb_ld(&bar[XB_TOPGEN]) == tg, bar);
            __builtin_amdgcn_fence(__ATOMIC_ACQUIRE, "agent");
            xb_add(&bar[XB_XGEN(b.x)], 1u);
            asm volatile("s_waitcnt vmcnt(0)" ::: "memory");
        } else {
            XB_SPIN(xb_ld(&bar[XB_XGEN(b.x)]) == gen, bar);
            __builtin_amdgcn_fence(__ATOMIC_ACQUIRE, "agent");
            asm volatile("s_waitcnt vmcnt(0)" ::: "memory");
        }
    }
    __syncthreads();
}

#ifndef PROBE_MASK
#define PROBE_MASK 0
#endif
__global__ void __launch_bounds__(NTHREADS, 2) fwd_kernel(Params p) {
    extern __shared__ __attribute__((aligned(16))) unsigned char lds_raw[];
    LAS unsigned char* lds = (LAS unsigned char*)lds_raw;
    unsigned char* ws = p.ws;
    float* mod = (float*)(ws + WS_MOD); float* fmod = (float*)(ws + WS_FMOD);
    bf16_t* H = (bf16_t*)(ws + WS_H);
    if (threadIdx.x < 4) ((LAS unsigned*)(lds + 131072))[threadIdx.x] = 0u;
    __syncthreads();
    XcdBarrier bar; bar.bar = (unsigned*)(ws + WS_BAR); bar.x = 0; bar.st = (volatile LAS unsigned*)(lds + 131072);
    if (p.coop) bar = xcd_barrier_post((unsigned*)(ws + WS_BAR), (volatile LAS unsigned*)(lds + 131072));
    for (int ph = p.ph_lo; ph < p.ph_hi; ++ph) {
        for (int rep = 0; rep < (((PROBE_MASK >> ph) & 1) ? 2 : 1); ++rep) {
        if (rep) __syncthreads();
        int tid = threadIdx.x; asm volatile("" : "+v"(tid));
        switch (ph) {
            case 0: p0_prologue(p, lds, tid); break;
            case 1: modulate_phase<false>(p.in[0], p.in[4], mod + 0, mod + 1024, 9216, H, nullptr, tid); break;
            case 4: modulate_phase<false>(p.out, p.in[8], mod + 3072, mod + 4096, 9216, H, nullptr, tid); break;
            case 12: modulate_phase<false>(p.out, p.in[24], mod + 6144, mod + 7168, 9216, H, nullptr, tid); break;
            case 15: modulate_phase<true>(p.out, p.in[30], fmod + 0, fmod + 1024, 2048, nullptr, p.out, tid, H, mod + 8192); break;
            case 7: prep_phase(p, tid); break;
            case 9: scan_phase(p, lds, tid); break;
            case 10: combine_phase(p, tid); break;
            default: {
                pg8::Gemm g; pg8::EpiGen E;
                E.mode = 0; E.O = nullptr; E.ldo = 0; E.base = nullptr; E.out = nullptr; E.gate = nullptr; E.gscale = 1.f; E.w0 = p.in[13]; E.a0 = p.in[15];
                g.M = M_;
                switch (ph) {
                    case 2: g.A = H; g.Bt = (const bf16_t*)(ws + WS_WGU1); g.N = 5632; g.K = 1024; E.mode = 1; E.O = (bf16_t*)(ws + WS_HID); E.ldo = 2816; break;
                    case 3: g.A = (const bf16_t*)(ws + WS_HID); g.Bt = (const bf16_t*)(ws + WS_WD1); g.N = 1024; g.K = 2816; E.mode = 2; E.base = p.in[0]; E.out = p.out; E.gate = mod + 2048; E.gscale = 0.5f; break;
                    case 5: g.A = H; g.Bt = (const bf16_t*)(ws + WS_WINC); g.N = 1536; g.K = 1024; E.mode = 0; E.O = (bf16_t*)(ws + WS_PROJC); E.ldo = 1536; break;
                    case 6: g.A = H; g.Bt = (const bf16_t*)(ws + WS_WINR); g.N = 1792; g.K = 1024; E.mode = 0; E.O = (bf16_t*)(ws + WS_PROJR); E.ldo = 1792; break;
                    case 8: g.A = (const bf16_t*)(ws + WS_AP); g.Bt = (const bf16_t*)(ws + WS_WLORA); g.N = 2560; g.K = 256; E.mode = 3; E.O = (bf16_t*)(ws + WS_OUT5); E.ldo = 512; break;
                    case 11: g.A = (const bf16_t*)(ws + WS_YMIX); g.Bt = (const bf16_t*)(ws + WS_WOUT); g.N = 1024; g.K = 1024; E.mode = 2; E.base = p.out; E.out = p.out; E.gate = mod + 5120; E.gscale = 1.0f; break;
                    case 13: g.A = H; g.Bt = (const bf16_t*)(ws + WS_WGU2); g.N = 5632; g.K = 1024; E.mode = 1; E.O = (bf16_t*)(ws + WS_HID); E.ldo = 2816; break;
                    default: g.A = (const bf16_t*)(ws + WS_HID); g.Bt = (const bf16_t*)(ws + WS_WD2); g.N = 1024; g.K = 2816; E.mode = 0; E.O = H; E.ldo = 1024; break;
                }
                pg8::StaticOrder S; S.init(g.M, g.N, (int)gridDim.x, (int)blockIdx.x);
                pg8::gemm_phase<pg8::EpiGen, pg8::StaticOrder>(lds, g, S, E, tid);
            } break;
        }
        }
        if (ph + 1 < p.ph_hi) {
            if (ph == 5) __syncthreads();
            else if (p.pad != 0) cg::this_grid().sync();
            else xcd_barrier(bar);
        }
    }
}

constexpr int N_PHASES = 16;
#ifndef ONE_LAUNCH
#define ONE_LAUNCH 1
#endif
extern "C" void kernel_launch(void* const* d_in, const int* in_sizes, int n_in, void* d_out, int out_size, void* d_ws, size_t ws_size, hipStream_t stream) {
    static int grid = 0;
    if (grid == 0) {
        int dev = 0, cus = 0, per_cu = 0;
        hipGetDevice(&dev);
        hipDeviceGetAttribute(&cus, hipDeviceAttributeMultiprocessorCount, dev);
        hipFuncSetAttribute((const void*)fwd_kernel, hipFuncAttributeMaxDynamicSharedMemorySize, LDS_BYTES);
        hipOccupancyMaxActiveBlocksPerMultiprocessor(&per_cu, (const void*)fwd_kernel, NTHREADS, LDS_BYTES);
        if (per_cu < 1) per_cu = 1;
        grid = cus * 1;
        if (grid <= 0) grid = 256;
        if (ws_size < WS_END) fprintf(stderr, "kernel_launch: workspace too small: %zu < %zu\n", ws_size, (size_t)WS_END);
        if (n_in != 31) fprintf(stderr, "kernel_launch: expected 31 inputs, got %d\n", n_in);
        (void)hipGetLastError();
    }
    Params p{};
    for (int i = 0; i < 31; ++i) p.in[i] = (const float*)d_in[i];
    p.out = (float*)d_out; p.ws = (unsigned char*)d_ws; p.pad = 0;
#if ONE_LAUNCH
    (void)hipMemsetAsync((char*)d_ws + WS_BAR, 0, 16384, stream);
    p.ph_lo = 0; p.ph_hi = N_PHASES; p.coop = 1;
    void* args[] = {&p};
    hipError_t e = hipLaunchCooperativeKernel((const void*)fwd_kernel, dim3(grid), dim3(NTHREADS), args, LDS_BYTES, stream);
    if (e != hipSuccess) fprintf(stderr, "cooperative launch failed: %s (grid %d)\n", hipGetErrorString(e), grid);
#else
    p.coop = 0;
    for (int ph = 0; ph < N_PHASES; ++ph) {
        p.ph_lo = ph; p.ph_hi = ph + 1;
        hipLaunchKernelGGL(fwd_kernel, dim3(grid), dim3(NTHREADS), LDS_BYTES, stream, p);
    }
#endif
}
```

```cpp
#include <hip/hip_runtime.h>
#include <hip/hip_cooperative_groups.h>
#include <cstdio>
namespace cg = cooperative_groups;
namespace pg8 {
#define PG8_LAS __attribute__((address_space(3)))
typedef unsigned short bf16_t;
typedef short bf16x8 __attribute__((ext_vector_type(8)));
typedef float f32x4 __attribute__((ext_vector_type(4)));
typedef unsigned u32x4 __attribute__((ext_vector_type(4)));
constexpr int BM = 256, BK = 64, HALF = 128, HTB = HALF * BK * 2  , STAGE_BYTES = 8 * HTB, NXCD = 8, WGM = 8;

__host__ __device__ __forceinline__ int lds_byte(int r, int c) { const int st = (r >> 4) * 2 + (c >> 5), rr = r & 15, cc = c & 31, ob = rr * 64 + cc * 2; return st * 1024 + (ob ^ (((ob >> 9) & 1) << 5)); }
__host__ __device__ __forceinline__ void stage_rc(int b, int& R, int& C) { const int st = b / 1024, sb = b % 1024, swz = sb ^ (((sb >> 9) & 1) << 5); R = (st >> 1) * 16 + swz / 64; C = (st & 1) * 32 + (swz % 64) / 2; }
__host__ __device__ __forceinline__ int perm32(int rho) { const int n = rho >> 4, i = rho & 15; return 8 * (i >> 2) + 4 * n + (i & 3); }

struct Unit { int pm, pn; };
struct Gemm { const bf16_t* A; const bf16_t* Bt; int M, N, K; };

struct StaticOrder {
    int nM, nN, nwg, G, c;
    __host__ __device__ void init(int M, int N, int G_, int c_) { nM = M / BM; nN = N / BM; nwg = nM * nN; G = G_; c = c_; }
    __host__ __device__ bool next(int i, Unit& u) const {
        const long L = (long)i * G + c; if (L >= nwg) return false;
        int wgid = (int)L; { const int q = nwg / NXCD, r = nwg % NXCD, xcd = wgid % NXCD, off = wgid / NXCD; wgid = (xcd < r ? xcd * (q + 1) : r * (q + 1) + (xcd - r) * q) + off; }
        const int nig = WGM * nN, gid = wgid / nig, fm = gid * WGM, gsz = (nM - fm) < WGM ? (nM - fm) : WGM;
        u.pm = fm + ((wgid % nig) % gsz); u.pn = (wgid % nig) / gsz; return true;
    }
    __device__ __forceinline__ void a_ready(const Unit&) const {}
    __device__ __forceinline__ void done(const Unit&) const {}
};
__device__ __forceinline__ unsigned cvt_pk_bf16(float lo, float hi) { unsigned r; asm volatile("v_cvt_pk_bf16_f32 %0, %1, %2" : "=v"(r) : "v"(lo), "v"(hi)); return r; }
template <class Epi, class Sched>
__device__ __forceinline__ void gemm_phase(PG8_LAS unsigned char* lds, const Gemm g, const Sched& S, const Epi& E, const int tid) {
    const int wid = __builtin_amdgcn_readfirstlane(tid >> 6), lane = tid & 63, wr = wid >> 2, wc = wid & 3, fr = lane & 15, fq = lane >> 4;
    const int K = g.K, nt = K / BK;
    unsigned voffA[2], voffB[2];
#pragma unroll
    for (int i = 0; i < 2; ++i) { int R, C; stage_rc(tid * 16 + i * 8192, R, C); const int Rb = Epi::PERM ? ((R & ~31) + perm32(R & 31)) : R;
        voffA[i] = (unsigned)(R * K + C) * 2u; voffB[i] = (unsigned)(Rb * K + C) * 2u; }
    const size_t kstep = (size_t)(BK * 2);
    const size_t hstep = (size_t)HALF * K * 2;
    const size_t tstep = 2 * hstep;
    const unsigned ldsw = (unsigned)wid * 1024u;
    const int aoff = lds_byte(wr * 64 + fr, fq * 8), boff = lds_byte(wc * 32 + fr, fq * 8);
#define PG8_SA(b, h) (((b) * 2 + (h)) * HTB)
#define PG8_SB(b, h) ((4 + (b) * 2 + (h)) * HTB)
#define PG8_STAGE(bufoff, gbase, voff) do { _Pragma("unroll") for (int _i = 0; _i < 2; ++_i) \
        __builtin_amdgcn_global_load_lds((const unsigned*)((const char*)(gbase) + (voff)[_i]), (PG8_LAS unsigned*)(lds + (bufoff) + ldsw + _i * 8192), 16, 0, 0); } while (0)
#define PG8_LDA(dst, b, h) do { _Pragma("unroll") for (int m = 0; m < 4; ++m) _Pragma("unroll") for (int k = 0; k < 2; ++k) dst[m][k] = *(const PG8_LAS bf16x8*)(lds + PG8_SA(b, h) + aoff + m * 2048 + k * 1024); } while (0)
#define PG8_LDB(dst, b, h) do { _Pragma("unroll") for (int n = 0; n < 2; ++n) _Pragma("unroll") for (int k = 0; k < 2; ++k) dst[n][k] = *(const PG8_LAS bf16x8*)(lds + PG8_SB(b, h) + boff + n * 2048 + k * 1024); } while (0)
#define PG8_MMA(ai, bj, At, Bt) do { __builtin_amdgcn_s_setprio(1); _Pragma("unroll") for (int m = 0; m < 4; ++m) _Pragma("unroll") for (int n = 0; n < 2; ++n) _Pragma("unroll") for (int k = 0; k < 2; ++k) \
        acc[ai][bj][m][n] = __builtin_amdgcn_mfma_f32_16x16x32_bf16(Bt[n][k], At[m][k], acc[ai][bj][m][n], 0, 0, 0); __builtin_amdgcn_s_setprio(0); } while (0)
#define PG8_WAIT_V(n) asm volatile("s_waitcnt vmcnt(" #n ")" ::: "memory")
#define PG8_WAIT_L(n) asm volatile("s_waitcnt lgkmcnt(" #n ")" ::: "memory")
#define PG8_BAR __builtin_amdgcn_s_barrier()
#define PG8_SCHED __builtin_amdgcn_sched_barrier(0)
    Unit cur, nxt; int ui = 0;
    if (!S.next(0, cur)) return;
    f32x4 acc[2][2][4][2];
#pragma unroll
    for (int a = 0; a < 2; ++a)
#pragma unroll
        for (int b = 0; b < 2; ++b)
#pragma unroll
            for (int m = 0; m < 4; ++m)
#pragma unroll
                for (int n = 0; n < 2; ++n) acc[a][b][m][n] = (f32x4){0.f, 0.f, 0.f, 0.f};
    bf16x8 At[4][2], B0[2][2], B1[2][2];
    const char* cA = (const char*)g.A + (size_t)cur.pm * tstep; const char* cB = (const char*)g.Bt + (size_t)cur.pn * tstep;
    S.a_ready(cur);
    PG8_STAGE(PG8_SB(0, 0), cB, voffB); PG8_STAGE(PG8_SA(0, 0), cA, voffA); PG8_STAGE(PG8_SB(0, 1), cB + hstep, voffB); PG8_STAGE(PG8_SA(0, 1), cA + hstep, voffA);
    if (wr == 1) PG8_BAR;
    PG8_WAIT_V(4); PG8_BAR;
    PG8_STAGE(PG8_SB(1, 0), cB + kstep, voffB); PG8_STAGE(PG8_SA(1, 0), cA + kstep, voffA); PG8_STAGE(PG8_SB(1, 1), cB + hstep + kstep, voffB);
    PG8_WAIT_V(6); PG8_BAR;
    for (;;) {
        const bool has_next = S.next(ui + 1, nxt);
        const char* nA = has_next ? (const char*)g.A + (size_t)nxt.pm * tstep : cA; const char* nB = has_next ? (const char*)g.Bt + (size_t)nxt.pn * tstep : cB;
        for (int t = 0; t < nt; t += 2) {
            const bool last = (t == nt - 2);
            const char* a1 = cA + (size_t)(t + 1) * kstep;
            const char* a2 = last ? nA : cA + (size_t)(t + 2) * kstep; const char* b2 = last ? nB : cB + (size_t)(t + 2) * kstep;
            const char* a3 = a2 + kstep; const char* b3 = b2 + kstep;
            if (last && has_next) S.a_ready(nxt);
            PG8_LDB(B0, 0, 0); PG8_SCHED; PG8_LDA(At, 0, 0); PG8_STAGE(PG8_SA(1, 1), a1 + hstep, voffA);
            PG8_WAIT_L(8); PG8_BAR; PG8_WAIT_L(0); PG8_MMA(0, 0, At, B0); PG8_BAR; PG8_SCHED;
            PG8_LDB(B1, 0, 1); PG8_STAGE(PG8_SB(0, 0), b2, voffB);
            PG8_BAR; PG8_WAIT_L(0); PG8_MMA(0, 1, At, B1); PG8_BAR;
            PG8_LDA(At, 0, 1); PG8_STAGE(PG8_SA(0, 0), a2, voffA);
            PG8_BAR; PG8_WAIT_L(0); PG8_MMA(1, 0, At, B0); PG8_BAR; PG8_SCHED;
            PG8_STAGE(PG8_SB(0, 1), b2 + hstep, voffB);
            PG8_WAIT_V(6); PG8_BAR; PG8_MMA(1, 1, At, B1); PG8_BAR;
            PG8_LDB(B0, 1, 0); PG8_SCHED; PG8_LDA(At, 1, 0); PG8_STAGE(PG8_SA(0, 1), a2 + hstep, voffA);
            PG8_WAIT_L(8); PG8_BAR; PG8_WAIT_L(0); PG8_MMA(0, 0, At, B0); PG8_BAR; PG8_SCHED;
            PG8_LDB(B1, 1, 1); PG8_STAGE(PG8_SB(1, 0), b3, voffB);
            PG8_BAR; PG8_WAIT_L(0); PG8_MMA(0, 1, At, B1); PG8_BAR;
            PG8_LDA(At, 1, 1); PG8_STAGE(PG8_SA(1, 0), a3, voffA);
            PG8_BAR; PG8_WAIT_L(0); PG8_MMA(1, 0, At, B0); PG8_BAR; PG8_SCHED;
            PG8_STAGE(PG8_SB(1, 1), b3 + hstep, voffB);
            PG8_WAIT_V(6); PG8_BAR; PG8_MMA(1, 1, At, B1); PG8_BAR;
        }
        if constexpr (!Epi::AFTER_DRAIN) { E(acc, cur, wr, wc, fr, fq); S.done(cur); }
        if (!has_next) break;
#pragma unroll
        for (int a = 0; a < 2; ++a)
#pragma unroll
            for (int b = 0; b < 2; ++b)
#pragma unroll
                for (int m = 0; m < 4; ++m)
#pragma unroll
                    for (int n = 0; n < 2; ++n) acc[a][b][m][n] = (f32x4){0.f, 0.f, 0.f, 0.f};
        cur = nxt; cA = nA; cB = nB; ++ui;
    }
    PG8_WAIT_V(0);
    if (wr == 0) PG8_BAR;
    PG8_BAR;
    if constexpr (Epi::AFTER_DRAIN) { E.fused(acc, cur, wr, wc, fr, fq, lds, wid, lane); S.done(cur); }
#undef PG8_SA
#undef PG8_SB
#undef PG8_STAGE
#undef PG8_LDA
#undef PG8_LDB
#undef PG8_MMA
#undef PG8_WAIT_V
#undef PG8_WAIT_L
#undef PG8_BAR
#undef PG8_SCHED
}
}

#define LAS __attribute__((address_space(3)))
typedef unsigned short bf16_t;
typedef float f32x4 __attribute__((ext_vector_type(4)));
typedef unsigned u32x4 __attribute__((ext_vector_type(4)));
typedef unsigned u32x2 __attribute__((ext_vector_type(2)));
constexpr int M_ = 32768, D_ = 1024, F_ = 2816, T_ = 8192;
constexpr int NTHREADS = 512;
constexpr int LDS_BYTES = 131072 + 16;
constexpr size_t SZ_TOK512 = (size_t)M_ * 512 * 2;
constexpr size_t WS_BAR = 0;
constexpr size_t WS_MOD = 16384;
constexpr size_t WS_FMOD = WS_MOD + 4 * 9216 * 4;
constexpr size_t WS_WGU1 = WS_FMOD + 4 * 2048 * 4;
constexpr size_t WS_WD1 = WS_WGU1 + (size_t)5632 * 1024 * 2;
constexpr size_t WS_WGU2 = WS_WD1 + (size_t)1024 * 2816 * 2;
constexpr size_t WS_WD2 = WS_WGU2 + (size_t)5632 * 1024 * 2;
constexpr size_t WS_WINC = WS_WD2 + (size_t)1024 * 2816 * 2;
constexpr size_t WS_WINR = WS_WINC + (size_t)1536 * 1024 * 2;
constexpr size_t WS_WLORA = WS_WINR + (size_t)1792 * 1024 * 2;
constexpr size_t WS_WOUT = WS_WLORA + (size_t)2560 * 256 * 2;
constexpr size_t WS_H = WS_WOUT + (size_t)1024 * 1024 * 2;
constexpr size_t WS_YMIX = WS_H + (size_t)M_ * 1024 * 2;
constexpr size_t WS_BIG = WS_YMIX + (size_t)M_ * 1024 * 2;
constexpr size_t WS_EXTRA = WS_BIG + (size_t)M_ * 3328 * 2;
constexpr size_t WS_END = WS_EXTRA + 3 * SZ_TOK512 + (size_t)M_ * 256 * 2;
constexpr size_t WS_HID = WS_BIG;
constexpr size_t WS_PROJC = WS_BIG;
constexpr size_t WS_PROJR = WS_BIG + (size_t)M_ * 1536 * 2;
constexpr size_t WS_OUT5 = WS_BIG;
constexpr size_t WS_YS1 = WS_BIG + 5 * SZ_TOK512;
constexpr size_t WS_R = WS_H;
constexpr size_t WS_K = WS_H + SZ_TOK512;
constexpr size_t WS_V = WS_EXTRA;
constexpr size_t WS_KK = WS_EXTRA + SZ_TOK512;
constexpr size_t WS_AP = WS_EXTRA + 2 * SZ_TOK512;
constexpr size_t WS_YS0 = WS_AP + (size_t)M_ * 256 * 2;
static_assert(WS_END <= 536870912ull, "workspace");

struct Params {
    const float* in[31];
    float* out; unsigned char* ws;
    int ph_lo, ph_hi, coop, pad;
};

__device__ __forceinline__ float sigm(float x) { return __builtin_amdgcn_rcpf(1.0f + __builtin_amdgcn_exp2f(-1.44269504f * x)); }
__device__ __forceinline__ unsigned pk_bf16(float lo, float hi) { return pg8::cvt_pk_bf16(lo, hi); }
__device__ __forceinline__ unsigned pk_f16(float lo, float hi) { typedef _Float16 h2 __attribute__((ext_vector_type(2))); h2 v; v.x = (_Float16)lo; v.y = (_Float16)hi; return __builtin_bit_cast(unsigned, v); }
__device__ __forceinline__ float bf_lo(unsigned w) { return __uint_as_float(w << 16); }
__device__ __forceinline__ float bf_hi(unsigned w) { return __uint_as_float(w & 0xffff0000u); }
__device__ __forceinline__ float h_lo(unsigned w) { typedef _Float16 h2 __attribute__((ext_vector_type(2))); h2 v = __builtin_bit_cast(h2, w); return (float)v.x; }
__device__ __forceinline__ float h_hi(unsigned w) { typedef _Float16 h2 __attribute__((ext_vector_type(2))); h2 v = __builtin_bit_cast(h2, w); return (float)v.y; }
__device__ __forceinline__ void unpack8_bf(const u32x4 w, float (&f)[8]) { f[0] = bf_lo(w.x); f[1] = bf_hi(w.x); f[2] = bf_lo(w.y); f[3] = bf_hi(w.y); f[4] = bf_lo(w.z); f[5] = bf_hi(w.z); f[6] = bf_lo(w.w); f[7] = bf_hi(w.w); }
__device__ __forceinline__ void unpack8_h(const u32x4 w, float (&f)[8]) { f[0] = h_lo(w.x); f[1] = h_hi(w.x); f[2] = h_lo(w.y); f[3] = h_hi(w.y); f[4] = h_lo(w.z); f[5] = h_hi(w.z); f[6] = h_lo(w.w); f[7] = h_hi(w.w); }
__device__ __forceinline__ u32x4 pack8_bf(const float (&f)[8]) { u32x4 w; w.x = pk_bf16(f[0], f[1]); w.y = pk_bf16(f[2], f[3]); w.z = pk_bf16(f[4], f[5]); w.w = pk_bf16(f[6], f[7]); return w; }
__device__ __forceinline__ void load8_bf(const bf16_t* p, float (&f)[8]) { unpack8_bf(*(const u32x4*)p, f); }

namespace pg8 {
struct EpiGen {
    static constexpr bool PERM = true, AFTER_DRAIN = false;
    int mode;
    bf16_t* O; int ldo;
    const float* base; float* out; const float* gate; float gscale;
    const float* w0; const float* a0;
    __device__ __forceinline__ void operator()(const f32x4 (&acc)[2][2][4][2], const Unit& u, int wr, int wc, int fr, int fq) const {
        const int row0 = u.pm * BM + wr * 64 + fr;
        if (mode == 1) {
            const int col0 = u.pn * 128 + wc * 32 + 8 * fq;
#pragma unroll
            for (int ai = 0; ai < 2; ++ai)
#pragma unroll
                for (int m = 0; m < 4; ++m) {
                    const f32x4 g0 = acc[ai][0][m][0], g1 = acc[ai][0][m][1], u0 = acc[ai][1][m][0], u1 = acc[ai][1][m][1];
                    float h[8];
#pragma unroll
                    for (int j = 0; j < 4; ++j) { h[j] = g0[j] * sigm(g0[j]) * u0[j]; h[4 + j] = g1[j] * sigm(g1[j]) * u1[j]; }
                    *(u32x4*)(O + (size_t)(row0 + ai * HALF + m * 16) * ldo + col0) = pack8_bf(h);
                }
        } else if (mode == 0) {
            const int col0 = u.pn * BM + wc * 32 + 8 * fq;
#pragma unroll
            for (int ai = 0; ai < 2; ++ai)
#pragma unroll
                for (int m = 0; m < 4; ++m)
#pragma unroll
                    for (int bj = 0; bj < 2; ++bj) {
                        const f32x4 v0 = acc[ai][bj][m][0], v1 = acc[ai][bj][m][1];
                        u32x4 w; w.x = cvt_pk_bf16(v0[0], v0[1]); w.y = cvt_pk_bf16(v0[2], v0[3]); w.z = cvt_pk_bf16(v1[0], v1[1]); w.w = cvt_pk_bf16(v1[2], v1[3]);
                        *(u32x4*)(O + (size_t)(row0 + ai * HALF + m * 16) * ldo + col0 + bj * HALF) = w;
                    }
        } else if (mode == 2) {
            const int b = u.pm >> 5;
            const int col0 = u.pn * BM + wc * 32 + 8 * fq;
            f32x4 gv[2][2];
#pragma unroll
            for (int bj = 0; bj < 2; ++bj)
#pragma unroll
                for (int n = 0; n < 2; ++n) gv[bj][n] = *(const f32x4*)(gate + (size_t)b * 9216 + col0 + bj * HALF + 4 * n) * gscale;
            f32x4 bs[3][2][2];
#define RES_LOAD(it) do { const size_t off_ = (size_t)(row0 + ((it) >> 2) * HALF + ((it) & 3) * 16) * 1024 + col0; \
                _Pragma("unroll") for (int bj = 0; bj < 2; ++bj) _Pragma("unroll") for (int n = 0; n < 2; ++n) bs[(it) % 3][bj][n] = *(const f32x4*)(base + off_ + bj * HALF + 4 * n); } while (0)
            RES_LOAD(0); RES_LOAD(1);
#pragma unroll
            for (int it = 0; it < 8; ++it) {
                if (it + 2 < 8) RES_LOAD(it + 2);
                const size_t off = (size_t)(row0 + (it >> 2) * HALF + (it & 3) * 16) * 1024 + col0;
#pragma unroll
                for (int bj = 0; bj < 2; ++bj)
#pragma unroll
                    for (int n = 0; n < 2; ++n) *(f32x4*)(out + off + bj * HALF + 4 * n) = bs[it % 3][bj][n] + gv[bj][n] * acc[it >> 2][bj][it & 3][n];
            }
#undef RES_LOAD
        } else {
            const int arr = u.pn >> 1;
            const int colt = (u.pn & 1) * 256 + wc * 32 + 8 * fq;
            bf16_t* Ob = O + (size_t)arr * ((size_t)32768 * 512);
            f32x4 bv[2][2];
#pragma unroll
            for (int bj = 0; bj < 2; ++bj)
#pragma unroll
                for (int n = 0; n < 2; ++n) {
                    const int c = colt + bj * HALF + 4 * n;
                    bv[bj][n] = arr < 2 ? *(const f32x4*)(w0 + arr * 512 + c) : (arr < 4 ? *(const f32x4*)(a0 + (arr - 2) * 512 + c) : (f32x4){0.f, 0.f, 0.f, 0.f});
                }
#pragma unroll
            for (int ai = 0; ai < 2; ++ai)
#pragma unroll
                for (int m = 0; m < 4; ++m)
#pragma unroll
                    for (int bj = 0; bj < 2; ++bj) {
                        f32x4 v0 = acc[ai][bj][m][0] + bv[bj][0], v1 = acc[ai][bj][m][1] + bv[bj][1];
                        u32x4 w;
                        if (arr < 4) {
                            const float sc = arr < 2 ? 0.87503877f : 1.0f;
#pragma unroll
                            for (int j = 0; j < 4; ++j) { v0[j] = sc * sigm(v0[j]); v1[j] = sc * sigm(v1[j]); }
                            w.x = pk_f16(v0[0], v0[1]); w.y = pk_f16(v0[2], v0[3]); w.z = pk_f16(v1[0], v1[1]); w.w = pk_f16(v1[2], v1[3]);
                        } else {
                            w.x = cvt_pk_bf16(v0[0], v0[1]); w.y = cvt_pk_bf16(v0[2], v0[3]); w.z = cvt_pk_bf16(v1[0], v1[1]); w.w = cvt_pk_bf16(v1[2], v1[3]);
                        }
                        *(u32x4*)(Ob + (size_t)(row0 + ai * HALF + m * 16) * 512 + colt + bj * HALF) = w;
                    }
        }
    }
};
}

__device__ __forceinline__ float wave_sum64(float v) {
#pragma unroll
    for (int o = 32; o >= 1; o >>= 1) v += __shfl_xor(v, o);
    return v;
}
__device__ __forceinline__ float sum8(float v) { v += __shfl_xor(v, 1); v += __shfl_xor(v, 2); v += __shfl_xor(v, 4); return v; }

__device__ __forceinline__ void p0_prologue(const Params& p, LAS unsigned char* lds, const int tid) {
    unsigned char* ws = p.ws;
    LAS float* sc = (LAS float*)lds;
    LAS float* red = (LAS float*)(lds + 16384);
    {
        const float* c = p.in[1];
        for (int i = tid; i < 4096; i += NTHREADS) { const float v = c[i]; sc[i] = v * sigm(v); }
    }
    __syncthreads();
    for (int cb = blockIdx.x; cb < 176; cb += gridDim.x) {
        const int cc = tid & 63, dg = tid >> 6, col = cb * 64 + cc;
        const float* W; const float* bias; float* dst; int ld, jc;
        if (col < 9216) { W = p.in[2]; bias = p.in[3]; dst = (float*)(ws + WS_MOD); ld = 9216; jc = col; }
        else { W = p.in[28]; bias = p.in[29]; dst = (float*)(ws + WS_FMOD); ld = 2048; jc = col - 9216; }
        float a0 = 0.f, a1 = 0.f, a2 = 0.f, a3 = 0.f;
        const float* wp = W + (size_t)(dg * 128) * ld + jc;
#pragma unroll 8
        for (int d = 0; d < 128; ++d) {
            const float w = wp[(size_t)d * ld]; const int dd = dg * 128 + d;
            a0 += sc[dd] * w; a1 += sc[1024 + dd] * w; a2 += sc[2048 + dd] * w; a3 += sc[3072 + dd] * w;
        }
        red[(dg * 64 + cc) * 4 + 0] = a0; red[(dg * 64 + cc) * 4 + 1] = a1; red[(dg * 64 + cc) * 4 + 2] = a2; red[(dg * 64 + cc) * 4 + 3] = a3;
        __syncthreads();
        if (tid < 256) {
            const int b = tid >> 6, c2 = tid & 63;
            float s = 0.f;
#pragma unroll
            for (int g = 0; g < 8; ++g) s += red[(g * 64 + c2) * 4 + b];
            const int col2 = cb * 64 + c2; const int jc2 = col2 < 9216 ? col2 : col2 - 9216;
            dst[(size_t)b * ld + jc2] = s + bias[jc2];
        }
        __syncthreads();
    }
    LAS float* tile = (LAS float*)(lds + 32768);
    for (int ti = blockIdx.x; ti < 5312; ti += gridDim.x) {
        int job, r;
        if (ti < 4224) { job = ti / 704; r = ti % 704; } else if (ti < 5056) { job = 6; r = ti - 4224; } else { job = 7; r = ti - 5056; }
        const float* W; int K, N;
        switch (job) {
            case 0: W = p.in[5]; K = 1024; N = 2816; break;
            case 1: W = p.in[6]; K = 1024; N = 2816; break;
            case 2: W = p.in[7]; K = 2816; N = 1024; break;
            case 3: W = p.in[25]; K = 1024; N = 2816; break;
            case 4: W = p.in[26]; K = 1024; N = 2816; break;
            case 5: W = p.in[27]; K = 2816; N = 1024; break;
            case 6: W = p.in[9]; K = 1024; N = 3328; break;
            default: W = p.in[23]; K = 1024; N = 1024; break;
        }
        const int nkt = K / 64, kt = r % nkt, ntile = r / nkt;
        {
            const int c = tid & 63, r0 = tid >> 6;
#pragma unroll
            for (int i = 0; i < 8; ++i) { const int kr = i * 8 + r0; tile[kr * 65 + c] = W[(size_t)(kt * 64 + kr) * N + ntile * 64 + c]; }
        }
        __syncthreads();
        {
            const int nl = tid >> 3, k8 = (tid & 7) * 8, n = ntile * 64 + nl;
            bf16_t* dst; int row;
            switch (job) {
                case 0: dst = (bf16_t*)(ws + WS_WGU1); row = 256 * (n >> 7) + (n & 127); break;
                case 1: dst = (bf16_t*)(ws + WS_WGU1); row = 256 * (n >> 7) + 128 + (n & 127); break;
                case 2: dst = (bf16_t*)(ws + WS_WD1); row = n; break;
                case 3: dst = (bf16_t*)(ws + WS_WGU2); row = 256 * (n >> 7) + (n & 127); break;
                case 4: dst = (bf16_t*)(ws + WS_WGU2); row = 256 * (n >> 7) + 128 + (n & 127); break;
                case 5: dst = (bf16_t*)(ws + WS_WD2); row = n; break;
                case 6: if (n < 1536) { dst = (bf16_t*)(ws + WS_WINC); row = n; } else { dst = (bf16_t*)(ws + WS_WINR); row = n - 1536; } break;
                default: dst = (bf16_t*)(ws + WS_WOUT); row = n; break;
            }
            float f[8];
#pragma unroll
            for (int q = 0; q < 8; ++q) f[q] = tile[(k8 + q) * 65 + nl];
            *(u32x4*)(dst + (size_t)row * K + kt * 64 + k8) = pack8_bf(f);
        }
        __syncthreads();
    }
    {
        bf16_t* WL = (bf16_t*)(ws + WS_WLORA);
        const float* w_up = p.in[14]; const float* a_up = p.in[16]; const float* g_up = p.in[17];
        for (int idx = blockIdx.x * NTHREADS + tid; idx < 2560 * 256; idx += gridDim.x * NTHREADS) {
            const int n = idx % 2560, k = idx / 2560;
            float val = 0.f;
            if (n < 1024) { const int d = n >> 9, c = n & 511; if (k < 64) val = w_up[(size_t)(d * 64 + k) * 512 + c]; }
            else if (n < 2048) { const int n2 = n - 1024, d = n2 >> 9, c = n2 & 511; if (k >= 64 && k < 128) val = a_up[(size_t)(d * 64 + k - 64) * 512 + c]; }
            else { const int c = n - 2048; if (k >= 128) val = g_up[(size_t)(k - 128) * 512 + c]; }
            WL[(size_t)n * 256 + k] = (bf16_t)(pk_bf16(val, val) & 0xffffu);
        }
    }
}

template <bool FINAL>
__device__ __forceinline__ void modulate_phase(const float* X, const float* gvec, const float* shift, const float* scale, int mod_ld, bf16_t* outH, float* outF, const int tid,
                                               const bf16_t* delta = nullptr, const float* dgate = nullptr) {
    const int lane = tid & 63, wid = tid >> 6;
    const int gw = blockIdx.x * 8 + wid, nw = gridDim.x * 8;
    f32x4 g4[4];
#pragma unroll
    for (int i = 0; i < 4; ++i) g4[i] = *(const f32x4*)(gvec + i * 256 + lane * 4);
    f32x4 x4[4], xn[4];
    if (gw < M_) {
#pragma unroll
        for (int i = 0; i < 4; ++i) x4[i] = *(const f32x4*)(X + (size_t)gw * 1024 + i * 256 + lane * 4);
    }
    for (int row = gw; row < M_; row += nw) {
        const int b = row >> 13;
        f32x4 sc4[4], sh4[4], gt[4]; u32x2 dw[4];
#pragma unroll
        for (int i = 0; i < 4; ++i) {
            sc4[i] = *(const f32x4*)(scale + (size_t)b * mod_ld + i * 256 + lane * 4);
            sh4[i] = *(const f32x4*)(shift + (size_t)b * mod_ld + i * 256 + lane * 4);
            if (FINAL) { dw[i] = *(const u32x2*)(delta + (size_t)row * 1024 + i * 256 + lane * 4); gt[i] = *(const f32x4*)(dgate + (size_t)b * 9216 + i * 256 + lane * 4); }
        }
        const int nrow = row + nw;
        if (nrow < M_) {
#pragma unroll
            for (int i = 0; i < 4; ++i) xn[i] = *(const f32x4*)(X + (size_t)nrow * 1024 + i * 256 + lane * 4);
        }
        float ss = 0.f;
#pragma unroll
        for (int i = 0; i < 4; ++i) {
            if (FINAL) x4[i] += (gt[i] * 0.5f) * (f32x4){bf_lo(dw[i].x), bf_hi(dw[i].x), bf_lo(dw[i].y), bf_hi(dw[i].y)};
            ss += x4[i][0] * x4[i][0] + x4[i][1] * x4[i][1] + x4[i][2] * x4[i][2] + x4[i][3] * x4[i][3];
        }
        ss = wave_sum64(ss);
        const float rstd = __builtin_amdgcn_rsqf(ss * (1.0f / 1024.0f) + 1e-6f);
#pragma unroll
        for (int i = 0; i < 4; ++i) {
            const f32x4 y = (x4[i] * rstd) * g4[i] * (sc4[i] + 1.0f) + sh4[i];
            if (FINAL) *(f32x4*)(outF + (size_t)row * 1024 + i * 256 + lane * 4) = y;
            else { u32x2 w; w.x = pk_bf16(y[0], y[1]); w.y = pk_bf16(y[2], y[3]); *(u32x2*)(outH + (size_t)row * 1024 + i * 256 + lane * 4) = w; }
        }
#pragma unroll
        for (int i = 0; i < 4; ++i) x4[i] = xn[i];
    }
}

__device__ __forceinline__ void prep_phase(const Params& p, const int tid) {
    const int lane = tid & 63, wid = tid >> 6;
    const int gw = blockIdx.x * 8 + wid, nw = gridDim.x * 8;
    unsigned char* ws = p.ws;
    const int c0 = lane * 8;
    {
        const bf16_t* PC = (const bf16_t*)(ws + WS_PROJC);
        bf16_t* YM = (bf16_t*)(ws + WS_YMIX);
        float cw0[8], cw1[8], cw2[8], cbv[8];
#pragma unroll
        for (int q = 0; q < 8; ++q) { cw0[q] = p.in[10][c0 + q]; cw1[q] = p.in[10][512 + c0 + q]; cw2[q] = p.in[10][1024 + c0 + q]; cbv[q] = p.in[11][c0 + q]; }
        for (int task = gw; task < M_ / 16; task += nw) {
            const int t0 = task * 16, tl0 = t0 & (T_ - 1);
            float up[8], uc[8], un[8], a[8], b[8];
            if (tl0 == 0) {
#pragma unroll
                for (int q = 0; q < 8; ++q) up[q] = 0.f;
            } else {
                load8_bf(PC + (size_t)(t0 - 1) * 1536 + 512 + c0, a); load8_bf(PC + (size_t)(t0 - 1) * 1536 + 1024 + c0, b);
#pragma unroll
                for (int q = 0; q < 8; ++q) up[q] = a[q] * b[q];
            }
            load8_bf(PC + (size_t)t0 * 1536 + 512 + c0, a); load8_bf(PC + (size_t)t0 * 1536 + 1024 + c0, b);
#pragma unroll
            for (int q = 0; q < 8; ++q) uc[q] = a[q] * b[q];
            for (int i = 0; i < 16; ++i) {
                const int tok = t0 + i;
                if (tl0 + i + 1 < T_) {
                    load8_bf(PC + (size_t)(tok + 1) * 1536 + 512 + c0, a); load8_bf(PC + (size_t)(tok + 1) * 1536 + 1024 + c0, b);
#pragma unroll
                    for (int q = 0; q < 8; ++q) un[q] = a[q] * b[q];
                } else {
#pragma unroll
                    for (int q = 0; q < 8; ++q) un[q] = 0.f;
                }
                float cbr[8], y[8];
                load8_bf(PC + (size_t)tok * 1536 + c0, cbr);
#pragma unroll
                for (int q = 0; q < 8; ++q) y[q] = cbr[q] * (cw0[q] * up[q] + cw1[q] * uc[q] + cw2[q] * un[q] + cbv[q]);
                *(u32x4*)(YM + (size_t)tok * 1024 + c0) = pack8_bf(y);
#pragma unroll
                for (int q = 0; q < 8; ++q) { up[q] = uc[q]; uc[q] = un[q]; }
            }
        }
    }
    {
        const bf16_t* PR = (const bf16_t*)(ws + WS_PROJR);
        bf16_t* Ro = (bf16_t*)(ws + WS_R); bf16_t* Ko = (bf16_t*)(ws + WS_K); bf16_t* Vo = (bf16_t*)(ws + WS_V); bf16_t* KKo = (bf16_t*)(ws + WS_KK); bf16_t* APo = (bf16_t*)(ws + WS_AP);
        const float* mu = p.in[12]; const float* k_k = p.in[18];
        float mur[8], muk[8], muv[8], mus[4], kkw[8];
#pragma unroll
        for (int q = 0; q < 8; ++q) { mur[q] = mu[c0 + q]; muk[q] = mu[512 + c0 + q]; muv[q] = mu[1024 + c0 + q]; kkw[q] = k_k[c0 + q]; }
#pragma unroll
        for (int q = 0; q < 4; ++q) mus[q] = mu[1536 + lane * 4 + q];
        for (int task = gw; task < M_ / 16; task += nw) {
            const int t0 = task * 16, tl0 = t0 & (T_ - 1);
            float pr[8], pk[8], pv[8], ps[4], cr[8], ck[8], cv[8], cs[4], nr[8], nk[8], nv[8], ns[4];
            if (tl0 == 0) {
#pragma unroll
                for (int q = 0; q < 8; ++q) { pr[q] = 0.f; pk[q] = 0.f; pv[q] = 0.f; }
#pragma unroll
                for (int q = 0; q < 4; ++q) ps[q] = 0.f;
            } else {
                const bf16_t* b = PR + (size_t)(t0 - 1) * 1792;
                load8_bf(b + c0, pr); load8_bf(b + 512 + c0, pk); load8_bf(b + 1024 + c0, pv);
                const u32x2 w = *(const u32x2*)(b + 1536 + lane * 4); ps[0] = bf_lo(w.x); ps[1] = bf_hi(w.x); ps[2] = bf_lo(w.y); ps[3] = bf_hi(w.y);
            }
            {
                const bf16_t* b = PR + (size_t)t0 * 1792;
                load8_bf(b + c0, cr); load8_bf(b + 512 + c0, ck); load8_bf(b + 1024 + c0, cv);
                const u32x2 w = *(const u32x2*)(b + 1536 + lane * 4); cs[0] = bf_lo(w.x); cs[1] = bf_hi(w.x); cs[2] = bf_lo(w.y); cs[3] = bf_hi(w.y);
            }
            for (int i = 0; i < 16; ++i) {
                const int tok = t0 + i;
                if (tl0 + i + 1 < T_) {
                    const bf16_t* b = PR + (size_t)(tok + 1) * 1792;
                    load8_bf(b + c0, nr); load8_bf(b + 512 + c0, nk); load8_bf(b + 1024 + c0, nv);
                    const u32x2 w = *(const u32x2*)(b + 1536 + lane * 4); ns[0] = bf_lo(w.x); ns[1] = bf_hi(w.x); ns[2] = bf_lo(w.y); ns[3] = bf_hi(w.y);
                } else {
#pragma unroll
                    for (int q = 0; q < 8; ++q) { nr[q] = 0.f; nk[q] = 0.f; nv[q] = 0.f; }
#pragma unroll
                    for (int q = 0; q < 4; ++q) ns[q] = 0.f;
                }
                float rs[8], ks[8], vs[8], kkv[8], ss = 0.f;
#pragma unroll
                for (int q = 0; q < 8; ++q) {
                    rs[q] = cr[q] + mur[q] * (0.5f * (pr[q] + nr[q]) - cr[q]);
                    ks[q] = ck[q] + muk[q] * (0.5f * (pk[q] + nk[q]) - ck[q]);
                    vs[q] = cv[q] + muv[q] * (0.5f * (pv[q] + nv[q]) - cv[q]);
                    kkv[q] = ks[q] * kkw[q]; ss += kkv[q] * kkv[q];
                }
                ss = sum8(ss);
                const float rn = __builtin_amdgcn_rsqf(ss + 1e-12f);
#pragma unroll
                for (int q = 0; q < 8; ++q) kkv[q] *= rn;
                *(u32x4*)(Ro + (size_t)tok * 512 + c0) = pack8_bf(rs);
                *(u32x4*)(Ko + (size_t)tok * 512 + c0) = pack8_bf(ks);
                *(u32x4*)(Vo + (size_t)tok * 512 + c0) = pack8_bf(vs);
                *(u32x4*)(KKo + (size_t)tok * 512 + c0) = pack8_bf(kkv);
                float sv[4];
#pragma unroll
                for (int q = 0; q < 4; ++q) {
                    const float s = cs[q] + mus[q] * (0.5f * (ps[q] + ns[q]) - cs[q]);
                    const float th = 2.0f * sigm(2.0f * s) - 1.0f, sg = sigm(s);
                    sv[q] = lane < 16 ? th : (lane < 32 ? s : sg);
                }
                { u32x2 w; w.x = pk_bf16(sv[0], sv[1]); w.y = pk_bf16(sv[2], sv[3]); *(u32x2*)(APo + (size_t)tok * 256 + lane * 4) = w; }
#pragma unroll
                for (int q = 0; q < 8; ++q) { pr[q] = cr[q]; pk[q] = ck[q]; pv[q] = cv[q]; cr[q] = nr[q]; ck[q] = nk[q]; cv[q] = nv[q]; }
#pragma unroll
                for (int q = 0; q < 4; ++q) { ps[q] = cs[q]; cs[q] = ns[q]; }
            }
        }
    }
}

typedef float f32x2 __attribute__((ext_vector_type(2)));
template <int CTRL> __device__ __forceinline__ float dpp_add(float x) { return x + __int_as_float(__builtin_amdgcn_update_dpp(0, __float_as_int(x), CTRL, 0xf, 0xf, false)); }
__device__ __forceinline__ float allsum16(float x) { x = dpp_add<0x121>(x); x = dpp_add<0x122>(x); x = dpp_add<0x124>(x); x = dpp_add<0x128>(x); return x; }
#define SCAN_BAR() asm volatile("s_waitcnt lgkmcnt(0)\n\ts_barrier" ::: "memory")
constexpr int SC_STEP = 1024, SC_CH = 32, SC_BUF = SC_STEP * SC_CH, SC_NCH = T_ / SC_CH;
typedef _Float16 h8 __attribute__((ext_vector_type(8)));
struct ScanOps { f32x4 W; u32x4 KKWR, KKAKD; f32x4 VC; };
template <int S> __device__ __forceinline__ void scan_ld(ScanOps& o, const unsigned bp, const unsigned vp) {
    asm volatile("ds_read_b128 %0, %1 offset:%2" : "=v"(o.KKWR) : "v"(bp), "n"(S * SC_STEP + 256));
    asm volatile("ds_read_b128 %0, %1 offset:%2" : "=v"(o.VC) : "v"(vp), "n"(S * SC_STEP));
    asm volatile("ds_read_b128 %0, %1 offset:%2" : "=v"(o.W) : "v"(bp), "n"(S * SC_STEP));
    asm volatile("ds_read_b128 %0, %1 offset:%2" : "=v"(o.KKAKD) : "v"(bp), "n"(S * SC_STEP + 512));
}
template <int N> __device__ __forceinline__ void scan_wait(ScanOps& o) {
    asm volatile("s_waitcnt lgkmcnt(%4)" : "+v"(o.W), "+v"(o.KKWR), "+v"(o.KKAKD), "+v"(o.VC) : "n"(N));
}
__device__ __forceinline__ float scan_step(float (&st)[4], const ScanOps& o) {
    const h8 a = __builtin_bit_cast(h8, o.KKWR), b = __builtin_bit_cast(h8, o.KKAKD);
    const float v = o.VC[0];
    float pa = __builtin_fmaf(st[0], (float)a[0], o.VC[3]); pa = __builtin_fmaf(st[1], (float)a[1], pa); pa = __builtin_fmaf(st[2], (float)a[2], pa);
    float pb = __builtin_fmaf(st[0], (float)a[4], o.VC[1]); pb = __builtin_fmaf(st[1], (float)a[5], pb); pb = __builtin_fmaf(st[2], (float)a[6], pb);
    float sa = __builtin_fmaf(st[3], (float)a[3], pa);
    const float pp = __builtin_fmaf(st[3], (float)a[7], pb);
    const float m0 = st[0] * o.W[0], m1 = st[1] * o.W[1];
    sa = dpp_add<0x121>(sa);
    const float m2 = st[2] * o.W[2], m3 = st[3] * o.W[3];
    sa = dpp_add<0x122>(sa);
    const float t0 = __builtin_fmaf((float)b[4], v, m0), t1 = __builtin_fmaf((float)b[5], v, m1);
    sa = dpp_add<0x124>(sa);
    const float t2 = __builtin_fmaf((float)b[6], v, m2), t3 = __builtin_fmaf((float)b[7], v, m3);
    sa = dpp_add<0x128>(sa);
    st[0] = __builtin_fmaf(-(float)b[0], sa, t0); st[1] = __builtin_fmaf(-(float)b[1], sa, t1); st[2] = __builtin_fmaf(-(float)b[2], sa, t2); st[3] = __builtin_fmaf(-(float)b[3], sa, t3);
    return __builtin_fmaf(-sa, o.VC[2], pp);
}
template <int CTRL> __device__ __forceinline__ float dpp_mov(float x) { return __int_as_float(__builtin_amdgcn_update_dpp(0, __float_as_int(x), CTRL, 0xf, 0xf, false)); }
__device__ __forceinline__ float transpose_reduce16(float (&p)[16], const int j) {
#define TRA1(h, l) "v_add_f32_dpp %" #h ", %" #h ", %" #h " row_ror:8 row_mask:0xf bank_mask:0xc\n\tv_add_f32_dpp %" #h ", %" #l ", %" #l " row_ror:8 row_mask:0xf bank_mask:0x3\n\t"
    asm volatile(TRA1(0, 8) TRA1(1, 9) TRA1(2, 10) TRA1(3, 11) TRA1(4, 12) TRA1(5, 13) TRA1(6, 14) TRA1(7, 15)
                 : "+v"(p[8]), "+v"(p[9]), "+v"(p[10]), "+v"(p[11]), "+v"(p[12]), "+v"(p[13]), "+v"(p[14]), "+v"(p[15])
                 : "v"(p[0]), "v"(p[1]), "v"(p[2]), "v"(p[3]), "v"(p[4]), "v"(p[5]), "v"(p[6]), "v"(p[7]));
#undef TRA1
#define TRB1(h, l) "v_add_f32_dpp %" #h ", %" #h ", %" #h " row_ror:4 row_mask:0xf bank_mask:0xa\n\tv_add_f32_dpp %" #h ", %" #l ", %" #l " row_ror:12 row_mask:0xf bank_mask:0x5\n\t"
    asm volatile(TRB1(0, 4) TRB1(1, 5) TRB1(2, 6) TRB1(3, 7)
                 : "+v"(p[12]), "+v"(p[13]), "+v"(p[14]), "+v"(p[15]) : "v"(p[8]), "v"(p[9]), "v"(p[10]), "v"(p[11]));
#undef TRB1
    const bool b1 = (j & 2) != 0, b0 = (j & 1) != 0;
    float q0, q1;
    { const float keep = b1 ? p[14] : p[12], send = b1 ? p[12] : p[14]; q0 = keep + dpp_mov<0x4E>(send); }
    { const float keep = b1 ? p[15] : p[13], send = b1 ? p[13] : p[15]; q1 = keep + dpp_mov<0x4E>(send); }
    const float keep = b0 ? q1 : q0, send = b0 ? q0 : q1;
    return keep + dpp_mov<0xB1>(send);
}
template <int S> __device__ __forceinline__ void scan_pair(float (&st)[4], float (&pacc)[16], ScanOps& A, ScanOps& B, const unsigned bp, const unsigned vp, const int j,
                                                          bf16_t* const yrow, const long ystep) {
    scan_ld<S + 1>(B, bp, vp);
    scan_wait<4>(A);
    pacc[S & 15] = scan_step(st, A);
    if constexpr (S + 2 < SC_CH) { scan_ld<S + 2>(A, bp, vp); scan_wait<4>(B); } else { scan_wait<0>(B); }
    pacc[(S + 1) & 15] = scan_step(st, B);
    if constexpr (((S + 2) & 15) == 0) {
        const float y = transpose_reduce16(pacc, j);
        yrow[(long)((S + 2) / 16 - 1) * 16 * ystep] = (bf16_t)(pk_bf16(y, y) & 0xffffu);
    }
    if constexpr (S + 2 < SC_CH) scan_pair<S + 2>(st, pacc, A, B, bp, vp, j, yrow, ystep);
}

__device__ __forceinline__ void scan_phase(const Params& p, LAS unsigned char* lds, const int tid) {
    const int lane = tid & 63, wid = __builtin_amdgcn_readfirstlane(tid >> 6);
    unsigned char* ws = p.ws;
    const bf16_t* Rg = (const bf16_t*)(ws + WS_R); const bf16_t* Kg = (const bf16_t*)(ws + WS_K); const bf16_t* Vg = (const bf16_t*)(ws + WS_V); const bf16_t* KKg = (const bf16_t*)(ws + WS_KK);
    for (int unit = blockIdx.x; unit < 256; unit += gridDim.x) {
        const int xcd = unit & 7, jj = unit >> 3, seq = xcd * 8 + (jj >> 2), rg = jj & 3;
        const int dir = seq >> 5, b = (seq >> 3) & 3, h = seq & 7;
        const size_t tokbase = (size_t)b * T_; const int ch0 = h * 64;
        const bf16_t* DWg = (const bf16_t*)(ws + WS_OUT5 + (size_t)dir * SZ_TOK512);
        const bf16_t* AAg = (const bf16_t*)(ws + WS_OUT5 + (size_t)(2 + dir) * SZ_TOK512);
        bf16_t* YSg = (bf16_t*)(ws + (dir ? WS_YS1 : WS_YS0));
        if (wid >= 4) {
            const int pt = tid - 256, sl = pt >> 4, kq = pt & 15;
            float ka4[4];
#pragma unroll
            for (int q = 0; q < 4; ++q) ka4[q] = p.in[19][ch0 + 4 * kq + q];
            u32x2 rr[2], kr[2], kkr[2], ar[2], dr[2]; unsigned short vr[2];
#define SC_LOAD(c) do { _Pragma("unroll") for (int e = 0; e < 2; ++e) { const int s = (c) * SC_CH + sl + 16 * e; const int t = dir ? (T_ - 1 - s) : s; \
                const size_t o = (tokbase + t) * 512 + ch0 + 4 * kq; \
                rr[e] = *(const u32x2*)(Rg + o); kr[e] = *(const u32x2*)(Kg + o); kkr[e] = *(const u32x2*)(KKg + o); ar[e] = *(const u32x2*)(AAg + o); dr[e] = *(const u32x2*)(DWg + o); \
                vr[e] = Vg[(tokbase + t) * 512 + ch0 + rg * 16 + kq]; } } while (0)
#define SC_CONV(bufi) do { _Pragma("unroll") for (int e = 0; e < 2; ++e) { LAS unsigned char* bp = lds + (bufi) * SC_BUF + (sl + 16 * e) * SC_STEP; \
                const float r_[4] = {bf_lo(rr[e].x), bf_hi(rr[e].x), bf_lo(rr[e].y), bf_hi(rr[e].y)}; \
                const float k_[4] = {bf_lo(kr[e].x), bf_hi(kr[e].x), bf_lo(kr[e].y), bf_hi(kr[e].y)}; \
                const float q_[4] = {bf_lo(kkr[e].x), bf_hi(kkr[e].x), bf_lo(kkr[e].y), bf_hi(kkr[e].y)}; \
                const float a_[4] = {h_lo(ar[e].x), h_hi(ar[e].x), h_lo(ar[e].y), h_hi(ar[e].y)}; \
                const float d_[4] = {h_lo(dr[e].x), h_hi(dr[e].x), h_lo(dr[e].y), h_hi(dr[e].y)}; \
                f32x4 w4; float kka4[4], kd4[4], wr4[4]; float c1 = 0.f, c2 = 0.f; \
                _Pragma("unroll") for (int q = 0; q < 4; ++q) { w4[q] = __builtin_amdgcn_exp2f(-d_[q]); kka4[q] = q_[q] * a_[q]; kd4[q] = k_[q] * (1.0f + (a_[q] - 1.0f) * ka4[q]); wr4[q] = w4[q] * r_[q]; \
                    c1 += kka4[q] * r_[q]; c2 += kd4[q] * r_[q]; } \
                c1 = allsum16(c1); c2 = allsum16(c2); \
                const float vv = __uint_as_float((unsigned)vr[e] << 16); \
                u32x4 kkwr, kkakd; kkwr.x = pk_f16(q_[0], q_[1]); kkwr.y = pk_f16(q_[2], q_[3]); kkwr.z = pk_f16(wr4[0], wr4[1]); kkwr.w = pk_f16(wr4[2], wr4[3]); \
                kkakd.x = pk_f16(kka4[0], kka4[1]); kkakd.y = pk_f16(kka4[2], kka4[3]); kkakd.z = pk_f16(kd4[0], kd4[1]); kkakd.w = pk_f16(kd4[2], kd4[3]); \
                *(LAS f32x4*)(bp + 16 * kq) = w4; *(LAS u32x4*)(bp + 256 + 16 * kq) = kkwr; *(LAS u32x4*)(bp + 512 + 16 * kq) = kkakd; \
                *(LAS f32x4*)(bp + 768 + 16 * kq) = (f32x4){vv, vv * c2 * 0.0625f, c1 * 0.0625f, 0.f}; } } while (0)
            SC_LOAD(0); SC_CONV(0); SC_LOAD(1);
            SCAN_BAR();
            for (int c = 0; c < SC_NCH; ++c) {
                if (c + 1 < SC_NCH) { SC_CONV((c + 1) & 1); }
                if (c + 2 < SC_NCH) { SC_LOAD(c + 2); }
                SCAN_BAR();
            }
#undef SC_LOAD
#undef SC_CONV
        } else {
            const int j = lane & 15, rr_ = lane >> 4, row = rg * 16 + wid * 4 + rr_;
            float st[4] = {0.f, 0.f, 0.f, 0.f};
            float pacc[16];
            const unsigned lbase = (unsigned)(size_t)lds;
            const long ystep = dir ? -512 : 512;
            SCAN_BAR();
            for (int c = 0; c < SC_NCH; ++c) {
                const unsigned cb = lbase + (c & 1) * SC_BUF;
                const unsigned bp = cb + 16 * j, vp = cb + 768 + 16 * (wid * 4 + rr_);
                const int sg = c * SC_CH + j; const int t = dir ? (T_ - 1 - sg) : sg;
                bf16_t* const yrow = YSg + (tokbase + t) * 512 + ch0 + row;
                ScanOps A, B;
                scan_ld<0>(A, bp, vp);
                scan_pair<0>(st, pacc, A, B, bp, vp, j, yrow, ystep);
                asm volatile("" : "+v"(st[0]), "+v"(st[1]), "+v"(st[2]), "+v"(st[3]));
                SCAN_BAR();
            }
        }
    }
}

__device__ __forceinline__ void combine_phase(const Params& p, const int tid) {
    const int lane = tid & 63, wid = tid >> 6;
    const int gw = blockIdx.x * 8 + wid, nw = gridDim.x * 8;
    unsigned char* ws = p.ws;
    const int c0 = lane * 8;
    const bf16_t* Y0 = (const bf16_t*)(ws + WS_YS0); const bf16_t* Y1 = (const bf16_t*)(ws + WS_YS1);
    const bf16_t* Rg = (const bf16_t*)(ws + WS_R); const bf16_t* Kg = (const bf16_t*)(ws + WS_K); const bf16_t* Vg = (const bf16_t*)(ws + WS_V);
    const bf16_t* A0 = (const bf16_t*)(ws + WS_OUT5 + 2 * SZ_TOK512); const bf16_t* A1 = (const bf16_t*)(ws + WS_OUT5 + 3 * SZ_TOK512); const bf16_t* Gg = (const bf16_t*)(ws + WS_OUT5 + 4 * SZ_TOK512);
    bf16_t* YM = (bf16_t*)(ws + WS_YMIX);
    float gnw[8], gnb[8], rk[8], ka[8];
#pragma unroll
    for (int q = 0; q < 8; ++q) { gnw[q] = p.in[21][c0 + q]; gnb[q] = p.in[22][c0 + q]; rk[q] = p.in[20][c0 + q]; ka[q] = p.in[19][c0 + q]; }
    u32x4 cur[8], nxt[8];
#define CMB_LOAD(dst, tk) do { const size_t o_ = (size_t)(tk) * 512 + c0; dst[0] = *(const u32x4*)(Y0 + o_); dst[1] = *(const u32x4*)(Y1 + o_); dst[2] = *(const u32x4*)(Rg + o_); dst[3] = *(const u32x4*)(Kg + o_); \
        dst[4] = *(const u32x4*)(Vg + o_); dst[5] = *(const u32x4*)(Gg + o_); dst[6] = *(const u32x4*)(A0 + o_); dst[7] = *(const u32x4*)(A1 + o_); } while (0)
    if (gw < M_) CMB_LOAD(cur, gw);
    for (int tok = gw; tok < M_; tok += nw) {
        if (tok + nw < M_) CMB_LOAD(nxt, tok + nw);
        float y0[8], y1[8], r[8], k[8], v[8], a0[8], a1[8], g[8];
        unpack8_bf(cur[0], y0); unpack8_bf(cur[1], y1); unpack8_bf(cur[2], r); unpack8_bf(cur[3], k); unpack8_bf(cur[4], v); unpack8_bf(cur[5], g);
        unpack8_h(cur[6], a0); unpack8_h(cur[7], a1);
        float y[8], s = 0.f, bs = 0.f;
#pragma unroll
        for (int q = 0; q < 8; ++q) { y[q] = y0[q] + y1[q]; s += y[q]; bs += r[q] * k[q] * rk[q] * (2.0f + (a0[q] + a1[q] - 2.0f) * ka[q]); }
        s = sum8(s); bs = sum8(bs);
        const float mean = s * (1.0f / 64.0f);
        float qv = 0.f;
#pragma unroll
        for (int q = 0; q < 8; ++q) { y[q] -= mean; qv += y[q] * y[q]; }
        qv = sum8(qv);
        const float rstd = __builtin_amdgcn_rsqf(qv * (1.0f / 64.0f) + 64e-5f);
        float o8[8];
#pragma unroll
        for (int q = 0; q < 8; ++q) o8[q] = ((y[q] * rstd) * gnw[q] + gnb[q] + bs * v[q]) * g[q];
        *(u32x4*)(YM + (size_t)tok * 1024 + 512 + c0) = pack8_bf(o8);
#pragma unroll
        for (int q = 0; q < 8; ++q) cur[q] = nxt[q];
    }
#undef CMB_LOAD
}

#define XB_TMO      128
#define XB_XCNT(j)  (256  + 64 * (j))
#define XB_XSUB(j)  (1280 + 64 * (j))
#define XB_XGEN(j)  (2304 + 64 * (j))
#define XB_TOP      3328
#define XB_TOPGEN   3392
#define XCD_BAR_WORDS 3456
#define XB_SPIN_CAP (1u << 18)

__device__ __forceinline__ unsigned xb_ld(unsigned* p)              { return __hip_atomic_load(p, __ATOMIC_RELAXED, __HIP_MEMORY_SCOPE_AGENT); }
__device__ __forceinline__ unsigned xb_add(unsigned* p, unsigned v) { return __hip_atomic_fetch_add(p, v, __ATOMIC_RELAXED, __HIP_MEMORY_SCOPE_AGENT); }
__device__ __forceinline__ unsigned xb_xcc_id() { return (unsigned)__builtin_amdgcn_s_getreg((3 << 11) | 20) & 0xFu; }
#define XB_SPIN(cond, bar) do { unsigned _sp = 0; while (cond) { __builtin_amdgcn_s_sleep(1); \
    if ((++_sp & 255u) == 0u) { if (xb_ld(&(bar)[XB_TMO])) break; if (_sp > XB_SPIN_CAP) { atomicAdd(&(bar)[XB_TMO], 1u); break; } } } } while (0)

struct XcdBarrier {
    unsigned* bar; unsigned x;
    volatile LAS unsigned* st;
};

__device__ __forceinline__ XcdBarrier xcd_barrier_post(unsigned* bar, volatile LAS unsigned* st) {
    XcdBarrier b; b.bar = bar; b.x = xb_xcc_id(); b.st = st;
    if (threadIdx.x == 0) (void)xb_add(&bar[XB_XCNT(b.x)], 1u);
    return b;
}
__device__ __forceinline__ void xcd_barrier_complete(unsigned* bar, unsigned x, unsigned& nloc, unsigned& nx) {
    const unsigned G = gridDim.x * gridDim.y * gridDim.z;
    unsigned sum, cnt, mine, sp = 0u;
    for (;;) {
        sum = 0u; cnt = 0u; mine = 0u;
#pragma unroll
        for (unsigned j = 0; j < 16; ++j) { const unsigned c = xb_ld(&bar[XB_XCNT(j)]); sum += c; cnt += (c > 0u) ? 1u : 0u; mine = (j == x) ? c : mine; }
        if (sum == G) break;
        __builtin_amdgcn_s_sleep(1);
        if ((++sp & 255u) == 0u) { if (xb_ld(&bar[XB_TMO])) break; if (sp > XB_SPIN_CAP) { atomicAdd(&bar[XB_TMO], 1u); break; } }
    }
    nloc = mine > 0u ? mine : 1u; nx = cnt > 0u ? cnt : 1u;
}

__device__ __forceinline__ void xcd_barrier(const XcdBarrier& b) {
    asm volatile("s_waitcnt vmcnt(0)" ::: "memory");
    __syncthreads();
    if (threadIdx.x == 0) {
        unsigned* bar = b.bar;
        __builtin_amdgcn_s_waitcnt(0);
        unsigned nloc = b.st[0], nx = b.st[1];
        if (nloc == 0u) { xcd_barrier_complete(bar, b.x, nloc, nx); b.st[0] = nloc; b.st[1] = nx; }
        const unsigned old = xb_add(&bar[XB_XSUB(b.x)], 1u);
        const unsigned gen = old / nloc;
        if (old + 1u == (gen + 1u) * nloc) {
            __builtin_amdgcn_fence(__ATOMIC_RELEASE, "agent");
            asm volatile("s_waitcnt vmcnt(0)" ::: "memory");
            const unsigned og = xb_add(&bar[XB_TOP], 1u);
            const unsigned tg = og / nx;
            if (og + 1u == (tg + 1u) * nx) xb_add(&bar[XB_TOPGEN], 1u);
            else XB_SPIN(xb_ld(&bar[XB_TOPGEN]) == tg, bar);
            __builtin_amdgcn_fence(__ATOMIC_ACQUIRE, "agent");
            xb_add(&bar[XB_XGEN(b.x)], 1u);
            asm volatile("s_waitcnt vmcnt(0)" ::: "memory");
        } else {
            XB_SPIN(xb_ld(&bar[XB_XGEN(b.x)]) == gen, bar);
            __builtin_amdgcn_fence(__ATOMIC_ACQUIRE, "agent");
            asm volatile("s_waitcnt vmcnt(0)" ::: "memory");
        }
    }
    __syncthreads();
}

#ifndef PROBE_MASK
#define PROBE_MASK 0
#endif
__global__ void __launch_bounds__(NTHREADS, 2) fwd_kernel(Params p) {
    extern __shared__ __attribute__((aligned(16))) unsigned char lds_raw[];
    LAS unsigned char* lds = (LAS unsigned char*)lds_raw;
    unsigned char* ws = p.ws;
    float* mod = (float*)(ws + WS_MOD); float* fmod = (float*)(ws + WS_FMOD);
    bf16_t* H = (bf16_t*)(ws + WS_H);
    if (threadIdx.x < 4) ((LAS unsigned*)(lds + 131072))[threadIdx.x] = 0u;
    __syncthreads();
    XcdBarrier bar; bar.bar = (unsigned*)(ws + WS_BAR); bar.x = 0; bar.st = (volatile LAS unsigned*)(lds + 131072);
    if (p.coop) bar = xcd_barrier_post((unsigned*)(ws + WS_BAR), (volatile LAS unsigned*)(lds + 131072));
    for (int ph = p.ph_lo; ph < p.ph_hi; ++ph) {
        for (int rep = 0; rep < (((PROBE_MASK >> ph) & 1) ? 2 : 1); ++rep) {
        if (rep) __syncthreads();
        int tid = threadIdx.x; asm volatile("" : "+v"(tid));
        switch (ph) {
            case 0: p0_prologue(p, lds, tid); break;
            case 1: modulate_phase<false>(p.in[0], p.in[4], mod + 0, mod + 1024, 9216, H, nullptr, tid); break;
            case 4: modulate_phase<false>(p.out, p.in[8], mod + 3072, mod + 4096, 9216, H, nullptr, tid); break;
            case 12: modulate_phase<false>(p.out, p.in[24], mod + 6144, mod + 7168, 9216, H, nullptr, tid); break;
            case 15: modulate_phase<true>(p.out, p.in[30], fmod + 0, fmod + 1024, 2048, nullptr, p.out, tid, H, mod + 8192); break;
            case 7: prep_phase(p, tid); break;
            case 9: scan_phase(p, lds, tid); break;
            case 10: combine_phase(p, tid); break;
            default: {
                pg8::Gemm g; pg8::EpiGen E;
                E.mode = 0; E.O = nullptr; E.ldo = 0; E.base = nullptr; E.out = nullptr; E.gate = nullptr; E.gscale = 1.f; E.w0 = p.in[13]; E.a0 = p.in[15];
                g.M = M_;
                switch (ph) {
                    case 2: g.A = H; g.Bt = (const bf16_t*)(ws + WS_WGU1); g.N = 5632; g.K = 1024; E.mode = 1; E.O = (bf16_t*)(ws + WS_HID); E.ldo = 2816; break;
                    case 3: g.A = (const bf16_t*)(ws + WS_HID); g.Bt = (const bf16_t*)(ws + WS_WD1); g.N = 1024; g.K = 2816; E.mode = 2; E.base = p.in[0]; E.out = p.out; E.gate = mod + 2048; E.gscale = 0.5f; break;
                    case 5: g.A = H; g.Bt = (const bf16_t*)(ws + WS_WINC); g.N = 1536; g.K = 1024; E.mode = 0; E.O = (bf16_t*)(ws + WS_PROJC); E.ldo = 1536; break;
                    case 6: g.A = H; g.Bt = (const bf16_t*)(ws + WS_WINR); g.N = 1792; g.K = 1024; E.mode = 0; E.O = (bf16_t*)(ws + WS_PROJR); E.ldo = 1792; break;
                    case 8: g.A = (const bf16_t*)(ws + WS_AP); g.Bt = (const bf16_t*)(ws + WS_WLORA); g.N = 2560; g.K = 256; E.mode = 3; E.O = (bf16_t*)(ws + WS_OUT5); E.ldo = 512; break;
                    case 11: g.A = (const bf16_t*)(ws + WS_YMIX); g.Bt = (const bf16_t*)(ws + WS_WOUT); g.N = 1024; g.K = 1024; E.mode = 2; E.base = p.out; E.out = p.out; E.gate = mod + 5120; E.gscale = 1.0f; break;
                    case 13: g.A = H; g.Bt = (const bf16_t*)(ws + WS_WGU2); g.N = 5632; g.K = 1024; E.mode = 1; E.O = (bf16_t*)(ws + WS_HID); E.ldo = 2816; break;
                    default: g.A = (const bf16_t*)(ws + WS_HID); g.Bt = (const bf16_t*)(ws + WS_WD2); g.N = 1024; g.K = 2816; E.mode = 0; E.O = H; E.ldo = 1024; break;
                }
                pg8::StaticOrder S; S.init(g.M, g.N, (int)gridDim.x, (int)blockIdx.x);
                pg8::gemm_phase<pg8::EpiGen, pg8::StaticOrder>(lds, g, S, E, tid);
            } break;
        }
        }
        if (ph + 1 < p.ph_hi) {
            if (ph == 5) __syncthreads();
            else if (p.pad != 0) cg::this_grid().sync();
            else xcd_barrier(bar);
        }
    }
}

constexpr int N_PHASES = 16;
#ifndef ONE_LAUNCH
#define ONE_LAUNCH 1
#endif
extern "C" void kernel_launch(void* const* d_in, const int* in_sizes, int n_in, void* d_out, int out_size, void* d_ws, size_t ws_size, hipStream_t stream) {
    static int grid = 0;
    if (grid == 0) {
        int dev = 0, cus = 0, per_cu = 0;
        hipGetDevice(&dev);
        hipDeviceGetAttribute(&cus, hipDeviceAttributeMultiprocessorCount, dev);
        hipFuncSetAttribute((const void*)fwd_kernel, hipFuncAttributeMaxDynamicSharedMemorySize, LDS_BYTES);
        hipOccupancyMaxActiveBlocksPerMultiprocessor(&per_cu, (const void*)fwd_kernel, NTHREADS, LDS_BYTES);
        if (per_cu < 1) per_cu = 1;
        grid = cus * 1;
        if (grid <= 0) grid = 256;
        if (ws_size < WS_END) fprintf(stderr, "kernel_launch: workspace too small: %zu < %zu\n", ws_size, (size_t)WS_END);
        if (n_in != 31) fprintf(stderr, "kernel_launch: expected 31 inputs, got %d\n", n_in);
        (void)hipGetLastError();
    }
    Params p{};
    for (int i = 0; i < 31; ++i) p.in[i] = (const float*)d_in[i];
    p.out = (float*)d_out; p.ws = (unsigned char*)d_ws; p.pad = 0;
#if ONE_LAUNCH
    (void)hipMemsetAsync((char*)d_ws + WS_BAR, 0, 16384, stream);
    p.ph_lo = 0; p.ph_hi = N_PHASES; p.coop = 1;
    void* args[] = {&p};
    hipError_t e = hipLaunchCooperativeKernel((const void*)fwd_kernel, dim3(grid), dim3(NTHREADS), args, LDS_BYTES, stream);
    if (e != hipSuccess) fprintf(stderr, "cooperative launch failed: %s (grid %d)\n", hipGetErrorString(e), grid);
#else
    p.coop = 0;
    for (int ph = 0; ph < N_PHASES; ++ph) {
        p.ph_lo = ph; p.ph_hi = ph + 1;
        hipLaunchKernelGGL(fwd_kernel, dim3(grid), dim3(NTHREADS), LDS_BYTES, stream, p);
    }
#endif
}
```

```cpp
#include <hip/hip_runtime.h>
#include <hip/hip_cooperative_groups.h>
#include <cstdio>
namespace cg = cooperative_groups;
namespace pg8 {
#define PG8_LAS __attribute__((address_space(3)))
typedef unsigned short bf16_t;
typedef short bf16x8 __attribute__((ext_vector_type(8)));
typedef float f32x4 __attribute__((ext_vector_type(4)));
typedef unsigned u32x4 __attribute__((ext_vector_type(4)));
constexpr int BM = 256, BK = 64, HALF = 128, HTB = HALF * BK * 2  , STAGE_BYTES = 8 * HTB, NXCD = 8, WGM = 8;

__host__ __device__ __forceinline__ int lds_byte(int r, int c) { const int st = (r >> 4) * 2 + (c >> 5), rr = r & 15, cc = c & 31, ob = rr * 64 + cc * 2; return st * 1024 + (ob ^ (((ob >> 9) & 1) << 5)); }
__host__ __device__ __forceinline__ void stage_rc(int b, int& R, int& C) { const int st = b / 1024, sb = b % 1024, swz = sb ^ (((sb >> 9) & 1) << 5); R = (st >> 1) * 16 + swz / 64; C = (st & 1) * 32 + (swz % 64) / 2; }
__host__ __device__ __forceinline__ int perm32(int rho) { const int n = rho >> 4, i = rho & 15; return 8 * (i >> 2) + 4 * n + (i & 3); }

struct Unit { int pm, pn; };
struct Gemm { const bf16_t* A; const bf16_t* Bt; int M, N, K; };

struct StaticOrder {
    int nM, nN, nwg, G, c;
    __host__ __device__ void init(int M, int N, int G_, int c_) { nM = M / BM; nN = N / BM; nwg = nM * nN; G = G_; c = c_; }
    __host__ __device__ bool next(int i, Unit& u) const {
        const long L = (long)i * G + c; if (L >= nwg) return false;
        int wgid = (int)L; { const int q = nwg / NXCD, r = nwg % NXCD, xcd = wgid % NXCD, off = wgid / NXCD; wgid = (xcd < r ? xcd * (q + 1) : r * (q + 1) + (xcd - r) * q) + off; }
        const int nig = WGM * nN, gid = wgid / nig, fm = gid * WGM, gsz = (nM - fm) < WGM ? (nM - fm) : WGM;
        u.pm = fm + ((wgid % nig) % gsz); u.pn = (wgid % nig) / gsz; return true;
    }
    __device__ __forceinline__ void a_ready(const Unit&) const {}
    __device__ __forceinline__ void done(const Unit&) const {}
};
__device__ __forceinline__ unsigned cvt_pk_bf16(float lo, float hi) { unsigned r; asm volatile("v_cvt_pk_bf16_f32 %0, %1, %2" : "=v"(r) : "v"(lo), "v"(hi)); return r; }
template <class Epi, class Sched>
__device__ __forceinline__ void gemm_phase(PG8_LAS unsigned char* lds, const Gemm g, const Sched& S, const Epi& E, const int tid) {
    const int wid = __builtin_amdgcn_readfirstlane(tid >> 6), lane = tid & 63, wr = wid >> 2, wc = wid & 3, fr = lane & 15, fq = lane >> 4;
    const int K = g.K, nt = K / BK;
    unsigned voffA[2], voffB[2];
#pragma unroll
    for (int i = 0; i < 2; ++i) { int R, C; stage_rc(tid * 16 + i * 8192, R, C); const int Rb = Epi::PERM ? ((R & ~31) + perm32(R & 31)) : R;
        voffA[i] = (unsigned)(R * K + C) * 2u; voffB[i] = (unsigned)(Rb * K + C) * 2u; }
    const size_t kstep = (size_t)(BK * 2);
    const size_t hstep = (size_t)HALF * K * 2;
    const size_t tstep = 2 * hstep;
    const unsigned ldsw = (unsigned)wid * 1024u;
    const int aoff = lds_byte(wr * 64 + fr, fq * 8), boff = lds_byte(wc * 32 + fr, fq * 8);
#define PG8_SA(b, h) (((b) * 2 + (h)) * HTB)
#define PG8_SB(b, h) ((4 + (b) * 2 + (h)) * HTB)
#define PG8_STAGE(bufoff, gbase, voff) do { _Pragma("unroll") for (int _i = 0; _i < 2; ++_i) \
        __builtin_amdgcn_global_load_lds((const unsigned*)((const char*)(gbase) + (voff)[_i]), (PG8_LAS unsigned*)(lds + (bufoff) + ldsw + _i * 8192), 16, 0, 0); } while (0)
#define PG8_LDA(dst, b, h) do { _Pragma("unroll") for (int m = 0; m < 4; ++m) _Pragma("unroll") for (int k = 0; k < 2; ++k) dst[m][k] = *(const PG8_LAS bf16x8*)(lds + PG8_SA(b, h) + aoff + m * 2048 + k * 1024); } while (0)
#define PG8_LDB(dst, b, h) do { _Pragma("unroll") for (int n = 0; n < 2; ++n) _Pragma("unroll") for (int k = 0; k < 2; ++k) dst[n][k] = *(const PG8_LAS bf16x8*)(lds + PG8_SB(b, h) + boff + n * 2048 + k * 1024); } while (0)
#define PG8_MMA(ai, bj, At, Bt) do { __builtin_amdgcn_s_setprio(1); _Pragma("unroll") for (int m = 0; m < 4; ++m) _Pragma("unroll") for (int n = 0; n < 2; ++n) _Pragma("unroll") for (int k = 0; k < 2; ++k) \
        acc[ai][bj][m][n] = __builtin_amdgcn_mfma_f32_16x16x32_bf16(Bt[n][k], At[m][k], acc[ai][bj][m][n], 0, 0, 0); __builtin_amdgcn_s_setprio(0); } while (0)
#define PG8_WAIT_V(n) asm volatile("s_waitcnt vmcnt(" #n ")" ::: "memory")
#define PG8_WAIT_L(n) asm volatile("s_waitcnt lgkmcnt(" #n ")" ::: "memory")
#define PG8_BAR __builtin_amdgcn_s_barrier()
#define PG8_SCHED __builtin_amdgcn_sched_barrier(0)
    Unit cur, nxt; int ui = 0;
    if (!S.next(0, cur)) return;
    f32x4 acc[2][2][4][2];
#pragma unroll
    for (int a = 0; a < 2; ++a)
#pragma unroll
        for (int b = 0; b < 2; ++b)
#pragma unroll
            for (int m = 0; m < 4; ++m)
#pragma unroll
                for (int n = 0; n < 2; ++n) acc[a][b][m][n] = (f32x4){0.f, 0.f, 0.f, 0.f};
    bf16x8 At[4][2], B0[2][2], B1[2][2];
    const char* cA = (const char*)g.A + (size_t)cur.pm * tstep; const char* cB = (const char*)g.Bt + (size_t)cur.pn * tstep;
    S.a_ready(cur);
    PG8_STAGE(PG8_SB(0, 0), cB, voffB); PG8_STAGE(PG8_SA(0, 0), cA, voffA); PG8_STAGE(PG8_SB(0, 1), cB + hstep, voffB); PG8_STAGE(PG8_SA(0, 1), cA + hstep, voffA);
    if (wr == 1) PG8_BAR;
    PG8_WAIT_V(4); PG8_BAR;
    PG8_STAGE(PG8_SB(1, 0), cB + kstep, voffB); PG8_STAGE(PG8_SA(1, 0), cA + kstep, voffA); PG8_STAGE(PG8_SB(1, 1), cB + hstep + kstep, voffB);
    PG8_WAIT_V(6); PG8_BAR;
    for (;;) {
        const bool has_next = S.next(ui + 1, nxt);
        const char* nA = has_next ? (const char*)g.A + (size_t)nxt.pm * tstep : cA; const char* nB = has_next ? (const char*)g.Bt + (size_t)nxt.pn * tstep : cB;
        for (int t = 0; t < nt; t += 2) {
            const bool last = (t == nt - 2);
            const char* a1 = cA + (size_t)(t + 1) * kstep;
            const char* a2 = last ? nA : cA + (size_t)(t + 2) * kstep; const char* b2 = last ? nB : cB + (size_t)(t + 2) * kstep;
            const char* a3 = a2 + kstep; const char* b3 = b2 + kstep;
            if (last && has_next) S.a_ready(nxt);
            PG8_LDB(B0, 0, 0); PG8_SCHED; PG8_LDA(At, 0, 0); PG8_STAGE(PG8_SA(1, 1), a1 + hstep, voffA);
            PG8_WAIT_L(8); PG8_BAR; PG8_WAIT_L(0); PG8_MMA(0, 0, At, B0); PG8_BAR; PG8_SCHED;
            PG8_LDB(B1, 0, 1); PG8_STAGE(PG8_SB(0, 0), b2, voffB);
            PG8_BAR; PG8_WAIT_L(0); PG8_MMA(0, 1, At, B1); PG8_BAR;
            PG8_LDA(At, 0, 1); PG8_STAGE(PG8_SA(0, 0), a2, voffA);
            PG8_BAR; PG8_WAIT_L(0); PG8_MMA(1, 0, At, B0); PG8_BAR; PG8_SCHED;
            PG8_STAGE(PG8_SB(0, 1), b2 + hstep, voffB);
            PG8_WAIT_V(6); PG8_BAR; PG8_MMA(1, 1, At, B1); PG8_BAR;
            PG8_LDB(B0, 1, 0); PG8_SCHED; PG8_LDA(At, 1, 0); PG8_STAGE(PG8_SA(0, 1), a2 + hstep, voffA);
            PG8_WAIT_L(8); PG8_BAR; PG8_WAIT_L(0); PG8_MMA(0, 0, At, B0); PG8_BAR; PG8_SCHED;
            PG8_LDB(B1, 1, 1); PG8_STAGE(PG8_SB(1, 0), b3, voffB);
            PG8_BAR; PG8_WAIT_L(0); PG8_MMA(0, 1, At, B1); PG8_BAR;
            PG8_LDA(At, 1, 1); PG8_STAGE(PG8_SA(1, 0), a3, voffA);
            PG8_BAR; PG8_WAIT_L(0); PG8_MMA(1, 0, At, B0); PG8_BAR; PG8_SCHED;
            PG8_STAGE(PG8_SB(1, 1), b3 + hstep, voffB);
            PG8_WAIT_V(6); PG8_BAR; PG8_MMA(1, 1, At, B1); PG8_BAR;
        }
        if constexpr (!Epi::AFTER_DRAIN) { E(acc, cur, wr, wc, fr, fq); S.done(cur); }
        if (!has_next) break;
#pragma unroll
        for (int a = 0; a < 2; ++a)
#pragma unroll
            for (int b = 0; b < 2; ++b)
#pragma unroll
                for (int m = 0; m < 4; ++m)
#pragma unroll
                    for (int n = 0; n < 2; ++n) acc[a][b][m][n] = (f32x4){0.f, 0.f, 0.f, 0.f};
        cur = nxt; cA = nA; cB = nB; ++ui;
    }
    PG8_WAIT_V(0);
    if (wr == 0) PG8_BAR;
    PG8_BAR;
    if constexpr (Epi::AFTER_DRAIN) { E.fused(acc, cur, wr, wc, fr, fq, lds, wid, lane); S.done(cur); }
#undef PG8_SA
#undef PG8_SB
#undef PG8_STAGE
#undef PG8_LDA
#undef PG8_LDB
#undef PG8_MMA
#undef PG8_WAIT_V
#undef PG8_WAIT_L
#undef PG8_BAR
#undef PG8_SCHED
}
}

#define LAS __attribute__((address_space(3)))
typedef unsigned short bf16_t;
typedef float f32x4 __attribute__((ext_vector_type(4)));
typedef unsigned u32x4 __attribute__((ext_vector_type(4)));
typedef unsigned u32x2 __attribute__((ext_vector_type(2)));
constexpr int M_ = 32768, D_ = 1024, F_ = 2816, T_ = 8192;
constexpr int NTHREADS = 512;
constexpr int LDS_BYTES = 131072 + 16;
constexpr size_t SZ_TOK512 = (size_t)M_ * 512 * 2;
constexpr size_t WS_BAR = 0;
constexpr size_t WS_MOD = 16384;
constexpr size_t WS_FMOD = WS_MOD + 4 * 9216 * 4;
constexpr size_t WS_WGU1 = WS_FMOD + 4 * 2048 * 4;
constexpr size_t WS_WD1 = WS_WGU1 + (size_t)5632 * 1024 * 2;
constexpr size_t WS_WGU2 = WS_WD1 + (size_t)1024 * 2816 * 2;
constexpr size_t WS_WD2 = WS_WGU2 + (size_t)5632 * 1024 * 2;
constexpr size_t WS_WINC = WS_WD2 + (size_t)1024 * 2816 * 2;
constexpr size_t WS_WINR = WS_WINC + (size_t)1536 * 1024 * 2;
constexpr size_t WS_WLORA = WS_WINR + (size_t)1792 * 1024 * 2;
constexpr size_t WS_WOUT = WS_WLORA + (size_t)2560 * 256 * 2;
constexpr size_t WS_H = WS_WOUT + (size_t)1024 * 1024 * 2;
constexpr size_t WS_YMIX = WS_H + (size_t)M_ * 1024 * 2;
constexpr size_t WS_BIG = WS_YMIX + (size_t)M_ * 1024 * 2;
constexpr size_t WS_EXTRA = WS_BIG + (size_t)M_ * 3328 * 2;
constexpr size_t WS_END = WS_EXTRA + 3 * SZ_TOK512 + (size_t)M_ * 256 * 2;
constexpr size_t WS_HID = WS_BIG;
constexpr size_t WS_PROJC = WS_BIG;
constexpr size_t WS_PROJR = WS_BIG + (size_t)M_ * 1536 * 2;
constexpr size_t WS_OUT5 = WS_BIG;
constexpr size_t WS_YS1 = WS_BIG + 5 * SZ_TOK512;
constexpr size_t WS_R = WS_H;
constexpr size_t WS_K = WS_H + SZ_TOK512;
constexpr size_t WS_V = WS_EXTRA;
constexpr size_t WS_KK = WS_EXTRA + SZ_TOK512;
constexpr size_t WS_AP = WS_EXTRA + 2 * SZ_TOK512;
constexpr size_t WS_YS0 = WS_AP + (size_t)M_ * 256 * 2;
static_assert(WS_END <= 536870912ull, "workspace");

struct Params {
    const float* in[31];
    float* out; unsigned char* ws;
    int ph_lo, ph_hi, coop, pad;
};

__device__ __forceinline__ float sigm(float x) { return __builtin_amdgcn_rcpf(1.0f + __builtin_amdgcn_exp2f(-1.44269504f * x)); }
__device__ __forceinline__ unsigned pk_bf16(float lo, float hi) { return pg8::cvt_pk_bf16(lo, hi); }
__device__ __forceinline__ unsigned pk_f16(float lo, float hi) { typedef _Float16 h2 __attribute__((ext_vector_type(2))); h2 v; v.x = (_Float16)lo; v.y = (_Float16)hi; return __builtin_bit_cast(unsigned, v); }
__device__ __forceinline__ float bf_lo(unsigned w) { return __uint_as_float(w << 16); }
__device__ __forceinline__ float bf_hi(unsigned w) { return __uint_as_float(w & 0xffff0000u); }
__device__ __forceinline__ float h_lo(unsigned w) { typedef _Float16 h2 __attribute__((ext_vector_type(2))); h2 v = __builtin_bit_cast(h2, w); return (float)v.x; }
__device__ __forceinline__ float h_hi(unsigned w) { typedef _Float16 h2 __attribute__((ext_vector_type(2))); h2 v = __builtin_bit_cast(h2, w); return (float)v.y; }
__device__ __forceinline__ void unpack8_bf(const u32x4 w, float (&f)[8]) { f[0] = bf_lo(w.x); f[1] = bf_hi(w.x); f[2] = bf_lo(w.y); f[3] = bf_hi(w.y); f[4] = bf_lo(w.z); f[5] = bf_hi(w.z); f[6] = bf_lo(w.w); f[7] = bf_hi(w.w); }
__device__ __forceinline__ void unpack8_h(const u32x4 w, float (&f)[8]) { f[0] = h_lo(w.x); f[1] = h_hi(w.x); f[2] = h_lo(w.y); f[3] = h_hi(w.y); f[4] = h_lo(w.z); f[5] = h_hi(w.z); f[6] = h_lo(w.w); f[7] = h_hi(w.w); }
__device__ __forceinline__ u32x4 pack8_bf(const float (&f)[8]) { u32x4 w; w.x = pk_bf16(f[0], f[1]); w.y = pk_bf16(f[2], f[3]); w.z = pk_bf16(f[4], f[5]); w.w = pk_bf16(f[6], f[7]); return w; }
__device__ __forceinline__ void load8_bf(const bf16_t* p, float (&f)[8]) { unpack8_bf(*(const u32x4*)p, f); }

namespace pg8 {
struct EpiGen {
    static constexpr bool PERM = true, AFTER_DRAIN = false;
    int mode;
    bf16_t* O; int ldo;
    const float* base; float* out; const float* gate; float gscale;
    const float* w0; const float* a0;
    __device__ __forceinline__ void operator()(const f32x4 (&acc)[2][2][4][2], const Unit& u, int wr, int wc, int fr, int fq) const {
        const int row0 = u.pm * BM + wr * 64 + fr;
        if (mode == 1) {
            const int col0 = u.pn * 128 + wc * 32 + 8 * fq;
#pragma unroll
            for (int ai = 0; ai < 2; ++ai)
#pragma unroll
                for (int m = 0; m < 4; ++m) {
                    const f32x4 g0 = acc[ai][0][m][0], g1 = acc[ai][0][m][1], u0 = acc[ai][1][m][0], u1 = acc[ai][1][m][1];
                    float h[8];
#pragma unroll
                    for (int j = 0; j < 4; ++j) { h[j] = g0[j] * sigm(g0[j]) * u0[j]; h[4 + j] = g1[j] * sigm(g1[j]) * u1[j]; }
                    *(u32x4*)(O + (size_t)(row0 + ai * HALF + m * 16) * ldo + col0) = pack8_bf(h);
                }
        } else if (mode == 0) {
            const int col0 = u.pn * BM + wc * 32 + 8 * fq;
#pragma unroll
            for (int ai = 0; ai < 2; ++ai)
#pragma unroll
                for (int m = 0; m < 4; ++m)
#pragma unroll
                    for (int bj = 0; bj < 2; ++bj) {
                        const f32x4 v0 = acc[ai][bj][m][0], v1 = acc[ai][bj][m][1];
                        u32x4 w; w.x = cvt_pk_bf16(v0[0], v0[1]); w.y = cvt_pk_bf16(v0[2], v0[3]); w.z = cvt_pk_bf16(v1[0], v1[1]); w.w = cvt_pk_bf16(v1[2], v1[3]);
                        *(u32x4*)(O + (size_t)(row0 + ai * HALF + m * 16) * ldo + col0 + bj * HALF) = w;
                    }
        } else if (mode == 2) {
            const int b = u.pm >> 5;
            const int col0 = u.pn * BM + wc * 32 + 8 * fq;
            f32x4 gv[2][2];
#pragma unroll
            for (int bj = 0; bj < 2; ++bj)
#pragma unroll
                for (int n = 0; n < 2; ++n) gv[bj][n] = *(const f32x4*)(gate + (size_t)b * 9216 + col0 + bj * HALF + 4 * n) * gscale;
            f32x4 bs[3][2][2];
#define RES_LOAD(it) do { const size_t off_ = (size_t)(row0 + ((it) >> 2) * HALF + ((it) & 3) * 16) * 1024 + col0; \
                _Pragma("unroll") for (int bj = 0; bj < 2; ++bj) _Pragma("unroll") for (int n = 0; n < 2; ++n) bs[(it) % 3][bj][n] = *(const f32x4*)(base + off_ + bj * HALF + 4 * n); } while (0)
            RES_LOAD(0); RES_LOAD(1);
#pragma unroll
            for (int it = 0; it < 8; ++it) {
                if (it + 2 < 8) RES_LOAD(it + 2);
                const size_t off = (size_t)(row0 + (it >> 2) * HALF + (it & 3) * 16) * 1024 + col0;
#pragma unroll
                for (int bj = 0; bj < 2; ++bj)
#pragma unroll
                    for (int n = 0; n < 2; ++n) *(f32x4*)(out + off + bj * HALF + 4 * n) = bs[it % 3][bj][n] + gv[bj][n] * acc[it >> 2][bj][it & 3][n];
            }
#undef RES_LOAD
        } else {
            const int arr = u.pn >> 1;
            const int colt = (u.pn & 1) * 256 + wc * 32 + 8 * fq;
            bf16_t* Ob = O + (size_t)arr * ((size_t)32768 * 512);
            f32x4 bv[2][2];
#pragma unroll
            for (int bj = 0; bj < 2; ++bj)
#pragma unroll
                for (int n = 0; n < 2; ++n) {
                    const int c = colt + bj * HALF + 4 * n;
                    bv[bj][n] = arr < 2 ? *(const f32x4*)(w0 + arr * 512 + c) : (arr < 4 ? *(const f32x4*)(a0 + (arr - 2) * 512 + c) : (f32x4){0.f, 0.f, 0.f, 0.f});
                }
#pragma unroll
            for (int ai = 0; ai < 2; ++ai)
#pragma unroll
                for (int m = 0; m < 4; ++m)
#pragma unroll
                    for (int bj = 0; bj < 2; ++bj) {
                        f32x4 v0 = acc[ai][bj][m][0] + bv[bj][0], v1 = acc[ai][bj][m][1] + bv[bj][1];
                        u32x4 w;
                        if (arr < 4) {
                            const float sc = arr < 2 ? 0.87503877f : 1.0f;
#pragma unroll
                            for (int j = 0; j < 4; ++j) { v0[j] = sc * sigm(v0[j]); v1[j] = sc * sigm(v1[j]); }
                            w.x = pk_f16(v0[0], v0[1]); w.y = pk_f16(v0[2], v0[3]); w.z = pk_f16(v1[0], v1[1]); w.w = pk_f16(v1[2], v1[3]);
                        } else {
                            w.x = cvt_pk_bf16(v0[0], v0[1]); w.y = cvt_pk_bf16(v0[2], v0[3]); w.z = cvt_pk_bf16(v1[0], v1[1]); w.w = cvt_pk_bf16(v1[2], v1[3]);
                        }
                        *(u32x4*)(Ob + (size_t)(row0 + ai * HALF + m * 16) * 512 + colt + bj * HALF) = w;
                    }
        }
    }
};
}

__device__ __forceinline__ float wave_sum64(float v) {
#pragma unroll
    for (int o = 32; o >= 1; o >>= 1) v += __shfl_xor(v, o);
    return v;
}
__device__ __forceinline__ float sum8(float v) { v += __shfl_xor(v, 1); v += __shfl_xor(v, 2); v += __shfl_xor(v, 4); return v; }

__device__ __forceinline__ void p0_prologue(const Params& p, LAS unsigned char* lds, const int tid) {
    unsigned char* ws = p.ws;
    LAS float* sc = (LAS float*)lds;
    LAS float* red = (LAS float*)(lds + 16384);
    {
        const float* c = p.in[1];
        for (int i = tid; i < 4096; i += NTHREADS) { const float v = c[i]; sc[i] = v * sigm(v); }
    }
    __syncthreads();
    for (int cb = blockIdx.x; cb < 176; cb += gridDim.x) {
        const int cc = tid & 63, dg = tid >> 6, col = cb * 64 + cc;
        const float* W; const float* bias; float* dst; int ld, jc;
        if (col < 9216) { W = p.in[2]; bias = p.in[3]; dst = (float*)(ws + WS_MOD); ld = 9216; jc = col; }
        else { W = p.in[28]; bias = p.in[29]; dst = (float*)(ws + WS_FMOD); ld = 2048; jc = col - 9216; }
        float a0 = 0.f, a1 = 0.f, a2 = 0.f, a3 = 0.f;
        const float* wp = W + (size_t)(dg * 128) * ld + jc;
#pragma unroll 8
        for (int d = 0; d < 128; ++d) {
            const float w = wp[(size_t)d * ld]; const int dd = dg * 128 + d;
            a0 += sc[dd] * w; a1 += sc[1024 + dd] * w; a2 += sc[2048 + dd] * w; a3 += sc[3072 + dd] * w;
        }
        red[(dg * 64 + cc) * 4 + 0] = a0; red[(dg * 64 + cc) * 4 + 1] = a1; red[(dg * 64 + cc) * 4 + 2] = a2; red[(dg * 64 + cc) * 4 + 3] = a3;
        __syncthreads();
        if (tid < 256) {
            const int b = tid >> 6, c2 = tid & 63;
            float s = 0.f;
#pragma unroll
            for (int g = 0; g < 8; ++g) s += red[(g * 64 + c2) * 4 + b];
            const int col2 = cb * 64 + c2; const int jc2 = col2 < 9216 ? col2 : col2 - 9216;
            dst[(size_t)b * ld + jc2] = s + bias[jc2];
        }
        __syncthreads();
    }
    LAS float* tile = (LAS float*)(lds + 32768);
#define WT_DECODE(ti_, job_, W_, K_, N_, kt_, nt_) do { int r_; \
        if ((ti_) < 4224) { job_ = (ti_) / 704; r_ = (ti_) % 704; } else if ((ti_) < 5056) { job_ = 6; r_ = (ti_) - 4224; } else { job_ = 7; r_ = (ti_) - 5056; } \
        switch (job_) { \
            case 0: W_ = p.in[5]; K_ = 1024; N_ = 2816; break; \
            case 1: W_ = p.in[6]; K_ = 1024; N_ = 2816; break; \
            case 2: W_ = p.in[7]; K_ = 2816; N_ = 1024; break; \
            case 3: W_ = p.in[25]; K_ = 1024; N_ = 2816; break; \
            case 4: W_ = p.in[26]; K_ = 1024; N_ = 2816; break; \
            case 5: W_ = p.in[27]; K_ = 2816; N_ = 1024; break; \
            case 6: W_ = p.in[9]; K_ = 1024; N_ = 3328; break; \
            default: W_ = p.in[23]; K_ = 1024; N_ = 1024; break; \
        } \
        const int nkt_ = K_ / 64; kt_ = r_ % nkt_; nt_ = r_ / nkt_; } while (0)
    {
        const int lc = tid & 63, lr0 = tid >> 6;
        float cur[8], nxt[8];
        int ti = blockIdx.x;
        if (ti < 5312) {
            int job, K, N, kt, ntile; const float* W;
            WT_DECODE(ti, job, W, K, N, kt, ntile);
#pragma unroll
            for (int i = 0; i < 8; ++i) cur[i] = W[(size_t)(kt * 64 + i * 8 + lr0) * N + ntile * 64 + lc];
        }
        for (; ti < 5312; ti += gridDim.x) {
            int job, K, N, kt, ntile; const float* W;
            WT_DECODE(ti, job, W, K, N, kt, ntile);
#pragma unroll
            for (int i = 0; i < 8; ++i) tile[(i * 8 + lr0) * 65 + lc] = cur[i];
            __syncthreads();
            const int tn = ti + gridDim.x;
            if (tn < 5312) {
                int job2, K2, N2, kt2, ntile2; const float* W2;
                WT_DECODE(tn, job2, W2, K2, N2, kt2, ntile2);
#pragma unroll
                for (int i = 0; i < 8; ++i) nxt[i] = W2[(size_t)(kt2 * 64 + i * 8 + lr0) * N2 + ntile2 * 64 + lc];
            }
            {
                const int nl = tid >> 3, k8 = (tid & 7) * 8, n = ntile * 64 + nl;
                bf16_t* dst; int row;
                switch (job) {
                    case 0: dst = (bf16_t*)(ws + WS_WGU1); row = 256 * (n >> 7) + (n & 127); break;
                    case 1: dst = (bf16_t*)(ws + WS_WGU1); row = 256 * (n >> 7) + 128 + (n & 127); break;
                    case 2: dst = (bf16_t*)(ws + WS_WD1); row = n; break;
                    case 3: dst = (bf16_t*)(ws + WS_WGU2); row = 256 * (n >> 7) + (n & 127); break;
                    case 4: dst = (bf16_t*)(ws + WS_WGU2); row = 256 * (n >> 7) + 128 + (n & 127); break;
                    case 5: dst = (bf16_t*)(ws + WS_WD2); row = n; break;
                    case 6: if (n < 1536) { dst = (bf16_t*)(ws + WS_WINC); row = n; } else { dst = (bf16_t*)(ws + WS_WINR); row = n - 1536; } break;
                    default: dst = (bf16_t*)(ws + WS_WOUT); row = n; break;
                }
                float f[8];
#pragma unroll
                for (int q = 0; q < 8; ++q) f[q] = tile[(k8 + q) * 65 + nl];
                *(u32x4*)(dst + (size_t)row * K + kt * 64 + k8) = pack8_bf(f);
            }
            __syncthreads();
#pragma unroll
            for (int i = 0; i < 8; ++i) cur[i] = nxt[i];
        }
    }
#undef WT_DECODE
    {
        bf16_t* WL = (bf16_t*)(ws + WS_WLORA);
        const float* w_up = p.in[14]; const float* a_up = p.in[16]; const float* g_up = p.in[17];
        for (int idx = blockIdx.x * NTHREADS + tid; idx < 2560 * 256; idx += gridDim.x * NTHREADS) {
            const int n = idx % 2560, k = idx / 2560;
            float val = 0.f;
            if (n < 1024) { const int d = n >> 9, c = n & 511; if (k < 64) val = w_up[(size_t)(d * 64 + k) * 512 + c]; }
            else if (n < 2048) { const int n2 = n - 1024, d = n2 >> 9, c = n2 & 511; if (k >= 64 && k < 128) val = a_up[(size_t)(d * 64 + k - 64) * 512 + c]; }
            else { const int c = n - 2048; if (k >= 128) val = g_up[(size_t)(k - 128) * 512 + c]; }
            WL[(size_t)n * 256 + k] = (bf16_t)(pk_bf16(val, val) & 0xffffu);
        }
    }
}

template <bool FINAL>
__device__ __forceinline__ void modulate_phase(const float* X, const float* gvec, const float* shift, const float* scale, int mod_ld, bf16_t* outH, float* outF, const int tid,
                                               const bf16_t* delta = nullptr, const float* dgate = nullptr) {
    const int lane = tid & 63, wid = tid >> 6;
    const int gw = blockIdx.x * 8 + wid, nw = gridDim.x * 8;
    f32x4 g4[4];
#pragma unroll
    for (int i = 0; i < 4; ++i) g4[i] = *(const f32x4*)(gvec + i * 256 + lane * 4);
    f32x4 x4[4], xn[4];
    if (gw < M_) {
#pragma unroll
        for (int i = 0; i < 4; ++i) x4[i] = *(const f32x4*)(X + (size_t)gw * 1024 + i * 256 + lane * 4);
    }
    for (int row = gw; row < M_; row += nw) {
        const int b = row >> 13;
        f32x4 sc4[4], sh4[4], gt[4]; u32x2 dw[4];
#pragma unroll
        for (int i = 0; i < 4; ++i) {
            sc4[i] = *(const f32x4*)(scale + (size_t)b * mod_ld + i * 256 + lane * 4);
            sh4[i] = *(const f32x4*)(shift + (size_t)b * mod_ld + i * 256 + lane * 4);
            if (FINAL) { dw[i] = *(const u32x2*)(delta + (size_t)row * 1024 + i * 256 + lane * 4); gt[i] = *(const f32x4*)(dgate + (size_t)b * 9216 + i * 256 + lane * 4); }
        }
        const int nrow = row + nw;
        if (nrow < M_) {
#pragma unroll
            for (int i = 0; i < 4; ++i) xn[i] = *(const f32x4*)(X + (size_t)nrow * 1024 + i * 256 + lane * 4);
        }
        float ss = 0.f;
#pragma unroll
        for (int i = 0; i < 4; ++i) {
            if (FINAL) x4[i] += (gt[i] * 0.5f) * (f32x4){bf_lo(dw[i].x), bf_hi(dw[i].x), bf_lo(dw[i].y), bf_hi(dw[i].y)};
            ss += x4[i][0] * x4[i][0] + x4[i][1] * x4[i][1] + x4[i][2] * x4[i][2] + x4[i][3] * x4[i][3];
        }
        ss = wave_sum64(ss);
        const float rstd = __builtin_amdgcn_rsqf(ss * (1.0f / 1024.0f) + 1e-6f);
#pragma unroll
        for (int i = 0; i < 4; ++i) {
            const f32x4 y = (x4[i] * rstd) * g4[i] * (sc4[i] + 1.0f) + sh4[i];
            if (FINAL) *(f32x4*)(outF + (size_t)row * 1024 + i * 256 + lane * 4) = y;
            else { u32x2 w; w.x = pk_bf16(y[0], y[1]); w.y = pk_bf16(y[2], y[3]); *(u32x2*)(outH + (size_t)row * 1024 + i * 256 + lane * 4) = w; }
        }
#pragma unroll
        for (int i = 0; i < 4; ++i) x4[i] = xn[i];
    }
}

__device__ __forceinline__ void prep_phase(const Params& p, const int tid) {
    const int lane = tid & 63, wid = tid >> 6;
    const int gw = blockIdx.x * 8 + wid, nw = gridDim.x * 8;
    unsigned char* ws = p.ws;
    const int c0 = lane * 8;
    {
        const bf16_t* PC = (const bf16_t*)(ws + WS_PROJC);
        bf16_t* YM = (bf16_t*)(ws + WS_YMIX);
        float cw0[8], cw1[8], cw2[8], cbv[8];
#pragma unroll
        for (int q = 0; q < 8; ++q) { cw0[q] = p.in[10][c0 + q]; cw1[q] = p.in[10][512 + c0 + q]; cw2[q] = p.in[10][1024 + c0 + q]; cbv[q] = p.in[11][c0 + q]; }
        for (int task = gw; task < M_ / 16; task += nw) {
            const int t0 = task * 16, tl0 = t0 & (T_ - 1);
            float up[8], uc[8], un[8], a[8], b[8];
            if (tl0 == 0) {
#pragma unroll
                for (int q = 0; q < 8; ++q) up[q] = 0.f;
            } else {
                load8_bf(PC + (size_t)(t0 - 1) * 1536 + 512 + c0, a); load8_bf(PC + (size_t)(t0 - 1) * 1536 + 1024 + c0, b);
#pragma unroll
                for (int q = 0; q < 8; ++q) up[q] = a[q] * b[q];
            }
            load8_bf(PC + (size_t)t0 * 1536 + 512 + c0, a); load8_bf(PC + (size_t)t0 * 1536 + 1024 + c0, b);
#pragma unroll
            for (int q = 0; q < 8; ++q) uc[q] = a[q] * b[q];
            for (int i = 0; i < 16; ++i) {
                const int tok = t0 + i;
                if (tl0 + i + 1 < T_) {
                    load8_bf(PC + (size_t)(tok + 1) * 1536 + 512 + c0, a); load8_bf(PC + (size_t)(tok + 1) * 1536 + 1024 + c0, b);
#pragma unroll
                    for (int q = 0; q < 8; ++q) un[q] = a[q] * b[q];
                } else {
#pragma unroll
                    for (int q = 0; q < 8; ++q) un[q] = 0.f;
                }
                float cbr[8], y[8];
                load8_bf(PC + (size_t)tok * 1536 + c0, cbr);
#pragma unroll
                for (int q = 0; q < 8; ++q) y[q] = cbr[q] * (cw0[q] * up[q] + cw1[q] * uc[q] + cw2[q] * un[q] + cbv[q]);
                *(u32x4*)(YM + (size_t)tok * 1024 + c0) = pack8_bf(y);
#pragma unroll
                for (int q = 0; q < 8; ++q) { up[q] = uc[q]; uc[q] = un[q]; }
            }
        }
    }
    {
        const bf16_t* PR = (const bf16_t*)(ws + WS_PROJR);
        bf16_t* Ro = (bf16_t*)(ws + WS_R); bf16_t* Ko = (bf16_t*)(ws + WS_K); bf16_t* Vo = (bf16_t*)(ws + WS_V); bf16_t* KKo = (bf16_t*)(ws + WS_KK); bf16_t* APo = (bf16_t*)(ws + WS_AP);
        const float* mu = p.in[12]; const float* k_k = p.in[18];
        float mur[8], muk[8], muv[8], mus[4], kkw[8];
#pragma unroll
        for (int q = 0; q < 8; ++q) { mur[q] = mu[c0 + q]; muk[q] = mu[512 + c0 + q]; muv[q] = mu[1024 + c0 + q]; kkw[q] = k_k[c0 + q]; }
#pragma unroll
        for (int q = 0; q < 4; ++q) mus[q] = mu[1536 + lane * 4 + q];
        for (int task = gw; task < M_ / 16; task += nw) {
            const int t0 = task * 16, tl0 = t0 & (T_ - 1);
            float pr[8], pk[8], pv[8], ps[4], cr[8], ck[8], cv[8], cs[4], nr[8], nk[8], nv[8], ns[4];
            if (tl0 == 0) {
#pragma unroll
                for (int q = 0; q < 8; ++q) { pr[q] = 0.f; pk[q] = 0.f; pv[q] = 0.f; }
#pragma unroll
                for (int q = 0; q < 4; ++q) ps[q] = 0.f;
            } else {
                const bf16_t* b = PR + (size_t)(t0 - 1) * 1792;
                load8_bf(b + c0, pr); load8_bf(b + 512 + c0, pk); load8_bf(b + 1024 + c0, pv);
                const u32x2 w = *(const u32x2*)(b + 1536 + lane * 4); ps[0] = bf_lo(w.x); ps[1] = bf_hi(w.x); ps[2] = bf_lo(w.y); ps[3] = bf_hi(w.y);
            }
            {
                const bf16_t* b = PR + (size_t)t0 * 1792;
                load8_bf(b + c0, cr); load8_bf(b + 512 + c0, ck); load8_bf(b + 1024 + c0, cv);
                const u32x2 w = *(const u32x2*)(b + 1536 + lane * 4); cs[0] = bf_lo(w.x); cs[1] = bf_hi(w.x); cs[2] = bf_lo(w.y); cs[3] = bf_hi(w.y);
            }
            for (int i = 0; i < 16; ++i) {
                const int tok = t0 + i;
                if (tl0 + i + 1 < T_) {
                    const bf16_t* b = PR + (size_t)(tok + 1) * 1792;
                    load8_bf(b + c0, nr); load8_bf(b + 512 + c0, nk); load8_bf(b + 1024 + c0, nv);
                    const u32x2 w = *(const u32x2*)(b + 1536 + lane * 4); ns[0] = bf_lo(w.x); ns[1] = bf_hi(w.x); ns[2] = bf_lo(w.y); ns[3] = bf_hi(w.y);
                } else {
#pragma unroll
                    for (int q = 0; q < 8; ++q) { nr[q] = 0.f; nk[q] = 0.f; nv[q] = 0.f; }
#pragma unroll
                    for (int q = 0; q < 4; ++q) ns[q] = 0.f;
                }
                float rs[8], ks[8], vs[8], kkv[8], ss = 0.f;
#pragma unroll
                for (int q = 0; q < 8; ++q) {
                    rs[q] = cr[q] + mur[q] * (0.5f * (pr[q] + nr[q]) - cr[q]);
                    ks[q] = ck[q] + muk[q] * (0.5f * (pk[q] + nk[q]) - ck[q]);
                    vs[q] = cv[q] + muv[q] * (0.5f * (pv[q] + nv[q]) - cv[q]);
                    kkv[q] = ks[q] * kkw[q]; ss += kkv[q] * kkv[q];
                }
                ss = sum8(ss);
                const float rn = __builtin_amdgcn_rsqf(ss + 1e-12f);
#pragma unroll
                for (int q = 0; q < 8; ++q) kkv[q] *= rn;
                *(u32x4*)(Ro + (size_t)tok * 512 + c0) = pack8_bf(rs);
                *(u32x4*)(Ko + (size_t)tok * 512 + c0) = pack8_bf(ks);
                *(u32x4*)(Vo + (size_t)tok * 512 + c0) = pack8_bf(vs);
                *(u32x4*)(KKo + (size_t)tok * 512 + c0) = pack8_bf(kkv);
                float sv[4];
#pragma unroll
                for (int q = 0; q < 4; ++q) {
                    const float s = cs[q] + mus[q] * (0.5f * (ps[q] + ns[q]) - cs[q]);
                    const float th = 2.0f * sigm(2.0f * s) - 1.0f, sg = sigm(s);
                    sv[q] = lane < 16 ? th : (lane < 32 ? s : sg);
                }
                { u32x2 w; w.x = pk_bf16(sv[0], sv[1]); w.y = pk_bf16(sv[2], sv[3]); *(u32x2*)(APo + (size_t)tok * 256 + lane * 4) = w; }
#pragma unroll
                for (int q = 0; q < 8; ++q) { pr[q] = cr[q]; pk[q] = ck[q]; pv[q] = cv[q]; cr[q] = nr[q]; ck[q] = nk[q]; cv[q] = nv[q]; }
#pragma unroll
                for (int q = 0; q < 4; ++q) { ps[q] = cs[q]; cs[q] = ns[q]; }
            }
        }
    }
}

typedef float f32x2 __attribute__((ext_vector_type(2)));
template <int CTRL> __device__ __forceinline__ float dpp_add(float x) { return x + __int_as_float(__builtin_amdgcn_update_dpp(0, __float_as_int(x), CTRL, 0xf, 0xf, false)); }
__device__ __forceinline__ float allsum16(float x) { x = dpp_add<0x121>(x); x = dpp_add<0x122>(x); x = dpp_add<0x124>(x); x = dpp_add<0x128>(x); return x; }
#define SCAN_BAR() asm volatile("s_waitcnt lgkmcnt(0)\n\ts_barrier" ::: "memory")
constexpr int SC_STEP = 1024, SC_CH = 64, SC_BUF = SC_STEP * SC_CH, SC_NCH = T_ / SC_CH;
typedef _Float16 h8 __attribute__((ext_vector_type(8)));
struct ScanOps { f32x4 W; u32x4 KKWR, KKAKD; f32x4 VC; };
template <int S> __device__ __forceinline__ void scan_ld(ScanOps& o, const unsigned bp, const unsigned vp) {
    asm volatile("ds_read_b128 %0, %1 offset:%2" : "=v"(o.KKWR) : "v"(bp), "n"(S * SC_STEP + 256));
    asm volatile("ds_read_b128 %0, %1 offset:%2" : "=v"(o.VC) : "v"(vp), "n"(S * SC_STEP));
    asm volatile("ds_read_b128 %0, %1 offset:%2" : "=v"(o.W) : "v"(bp), "n"(S * SC_STEP));
    asm volatile("ds_read_b128 %0, %1 offset:%2" : "=v"(o.KKAKD) : "v"(bp), "n"(S * SC_STEP + 512));
}
template <int N> __device__ __forceinline__ void scan_wait(ScanOps& o) {
    asm volatile("s_waitcnt lgkmcnt(%4)" : "+v"(o.W), "+v"(o.KKWR), "+v"(o.KKAKD), "+v"(o.VC) : "n"(N));
}
__device__ __forceinline__ float scan_step(float (&st)[4], const ScanOps& o) {
    const h8 a = __builtin_bit_cast(h8, o.KKWR), b = __builtin_bit_cast(h8, o.KKAKD);
    const float v = o.VC[0];
    float pa = __builtin_fmaf(st[0], (float)a[0], o.VC[3]); pa = __builtin_fmaf(st[1], (float)a[1], pa); pa = __builtin_fmaf(st[2], (float)a[2], pa);
    float pb = __builtin_fmaf(st[0], (float)a[4], o.VC[1]); pb = __builtin_fmaf(st[1], (float)a[5], pb); pb = __builtin_fmaf(st[2], (float)a[6], pb);
    float sa = __builtin_fmaf(st[3], (float)a[3], pa);
    const float pp = __builtin_fmaf(st[3], (float)a[7], pb);
    const float m0 = st[0] * o.W[0], m1 = st[1] * o.W[1];
    sa = dpp_add<0x121>(sa);
    const float m2 = st[2] * o.W[2], m3 = st[3] * o.W[3];
    sa = dpp_add<0x122>(sa);
    const float t0 = __builtin_fmaf((float)b[4], v, m0), t1 = __builtin_fmaf((float)b[5], v, m1);
    sa = dpp_add<0x124>(sa);
    const float t2 = __builtin_fmaf((float)b[6], v, m2), t3 = __builtin_fmaf((float)b[7], v, m3);
    sa = dpp_add<0x128>(sa);
    st[0] = __builtin_fmaf(-(float)b[0], sa, t0); st[1] = __builtin_fmaf(-(float)b[1], sa, t1); st[2] = __builtin_fmaf(-(float)b[2], sa, t2); st[3] = __builtin_fmaf(-(float)b[3], sa, t3);
    return __builtin_fmaf(-sa, o.VC[2], pp);
}
template <int CTRL> __device__ __forceinline__ float dpp_mov(float x) { return __int_as_float(__builtin_amdgcn_update_dpp(0, __float_as_int(x), CTRL, 0xf, 0xf, false)); }
__device__ __forceinline__ float transpose_reduce16(float (&p)[16], const int j) {
#define TRA1(h, l) "v_add_f32_dpp %" #h ", %" #h ", %" #h " row_ror:8 row_mask:0xf bank_mask:0xc\n\tv_add_f32_dpp %" #h ", %" #l ", %" #l " row_ror:8 row_mask:0xf bank_mask:0x3\n\t"
    asm volatile(TRA1(0, 8) TRA1(1, 9) TRA1(2, 10) TRA1(3, 11) TRA1(4, 12) TRA1(5, 13) TRA1(6, 14) TRA1(7, 15)
                 : "+v"(p[8]), "+v"(p[9]), "+v"(p[10]), "+v"(p[11]), "+v"(p[12]), "+v"(p[13]), "+v"(p[14]), "+v"(p[15])
                 : "v"(p[0]), "v"(p[1]), "v"(p[2]), "v"(p[3]), "v"(p[4]), "v"(p[5]), "v"(p[6]), "v"(p[7]));
#undef TRA1
#define TRB1(h, l) "v_add_f32_dpp %" #h ", %" #h ", %" #h " row_ror:4 row_mask:0xf bank_mask:0xa\n\tv_add_f32_dpp %" #h ", %" #l ", %" #l " row_ror:12 row_mask:0xf bank_mask:0x5\n\t"
    asm volatile(TRB1(0, 4) TRB1(1, 5) TRB1(2, 6) TRB1(3, 7)
                 : "+v"(p[12]), "+v"(p[13]), "+v"(p[14]), "+v"(p[15]) : "v"(p[8]), "v"(p[9]), "v"(p[10]), "v"(p[11]));
#undef TRB1
    const bool b1 = (j & 2) != 0, b0 = (j & 1) != 0;
    float q0, q1;
    { const float keep = b1 ? p[14] : p[12], send = b1 ? p[12] : p[14]; q0 = keep + dpp_mov<0x4E>(send); }
    { const float keep = b1 ? p[15] : p[13], send = b1 ? p[13] : p[15]; q1 = keep + dpp_mov<0x4E>(send); }
    const float keep = b0 ? q1 : q0, send = b0 ? q0 : q1;
    return keep + dpp_mov<0xB1>(send);
}
template <int S> __device__ __forceinline__ void scan_pair(float (&st)[4], float (&pacc)[16], ScanOps& A, ScanOps& B, const unsigned bp, const unsigned vp, const int j,
                                                          bf16_t* const yrow, const long ystep) {
    scan_ld<S + 1>(B, bp, vp);
    scan_wait<4>(A);
    pacc[S & 15] = scan_step(st, A);
    if constexpr (S + 2 < SC_CH) { scan_ld<S + 2>(A, bp, vp); scan_wait<4>(B); } else { scan_wait<0>(B); }
    pacc[(S + 1) & 15] = scan_step(st, B);
    if constexpr (((S + 2) & 15) == 0) {
        const float y = transpose_reduce16(pacc, j);
        yrow[(long)((S + 2) / 16 - 1) * 16 * ystep] = (bf16_t)(pk_bf16(y, y) & 0xffffu);
    }
    if constexpr (S + 2 < SC_CH) scan_pair<S + 2>(st, pacc, A, B, bp, vp, j, yrow, ystep);
}

__device__ __forceinline__ void scan_phase(const Params& p, LAS unsigned char* lds, const int tid) {
    const int lane = tid & 63, wid = __builtin_amdgcn_readfirstlane(tid >> 6);
    unsigned char* ws = p.ws;
    const bf16_t* Rg = (const bf16_t*)(ws + WS_R); const bf16_t* Kg = (const bf16_t*)(ws + WS_K); const bf16_t* Vg = (const bf16_t*)(ws + WS_V); const bf16_t* KKg = (const bf16_t*)(ws + WS_KK);
    for (int unit = blockIdx.x; unit < 256; unit += gridDim.x) {
        const int xcd = unit & 7, jj = unit >> 3, seq = xcd * 8 + (jj >> 2), rg = jj & 3;
        const int dir = seq >> 5, b = (seq >> 3) & 3, h = seq & 7;
        const size_t tokbase = (size_t)b * T_; const int ch0 = h * 64;
        const bf16_t* DWg = (const bf16_t*)(ws + WS_OUT5 + (size_t)dir * SZ_TOK512);
        const bf16_t* AAg = (const bf16_t*)(ws + WS_OUT5 + (size_t)(2 + dir) * SZ_TOK512);
        bf16_t* YSg = (bf16_t*)(ws + (dir ? WS_YS1 : WS_YS0));
        if (wid >= 4) {
            const int pt = tid - 256, sl = pt >> 4, kq = pt & 15;
            float ka4[4];
#pragma unroll
            for (int q = 0; q < 4; ++q) ka4[q] = p.in[19][ch0 + 4 * kq + q];
            u32x2 rr[4], kr[4], kkr[4], ar[4], dr[4]; unsigned short vr[4];
#define SC_LOAD(c) do { _Pragma("unroll") for (int e = 0; e < 4; ++e) { const int s = (c) * SC_CH + sl + 16 * e; const int t = dir ? (T_ - 1 - s) : s; \
                const size_t o = (tokbase + t) * 512 + ch0 + 4 * kq; \
                rr[e] = *(const u32x2*)(Rg + o); kr[e] = *(const u32x2*)(Kg + o); kkr[e] = *(const u32x2*)(KKg + o); ar[e] = *(const u32x2*)(AAg + o); dr[e] = *(const u32x2*)(DWg + o); \
                vr[e] = Vg[(tokbase + t) * 512 + ch0 + rg * 16 + kq]; } } while (0)
#define SC_CONV(bufi) do { _Pragma("unroll") for (int e = 0; e < 4; ++e) { LAS unsigned char* bp = lds + (bufi) * SC_BUF + (sl + 16 * e) * SC_STEP; \
                const float r_[4] = {bf_lo(rr[e].x), bf_hi(rr[e].x), bf_lo(rr[e].y), bf_hi(rr[e].y)}; \
                const float k_[4] = {bf_lo(kr[e].x), bf_hi(kr[e].x), bf_lo(kr[e].y), bf_hi(kr[e].y)}; \
                const float q_[4] = {bf_lo(kkr[e].x), bf_hi(kkr[e].x), bf_lo(kkr[e].y), bf_hi(kkr[e].y)}; \
                const float a_[4] = {h_lo(ar[e].x), h_hi(ar[e].x), h_lo(ar[e].y), h_hi(ar[e].y)}; \
                const float d_[4] = {h_lo(dr[e].x), h_hi(dr[e].x), h_lo(dr[e].y), h_hi(dr[e].y)}; \
                f32x4 w4; float kka4[4], kd4[4], wr4[4]; float c1 = 0.f, c2 = 0.f; \
                _Pragma("unroll") for (int q = 0; q < 4; ++q) { w4[q] = __builtin_amdgcn_exp2f(-d_[q]); kka4[q] = q_[q] * a_[q]; kd4[q] = k_[q] * (1.0f + (a_[q] - 1.0f) * ka4[q]); wr4[q] = w4[q] * r_[q]; \
                    c1 += kka4[q] * r_[q]; c2 += kd4[q] * r_[q]; } \
                c1 = allsum16(c1); c2 = allsum16(c2); \
                const float vv = __uint_as_float((unsigned)vr[e] << 16); \
                u32x4 kkwr, kkakd; kkwr.x = pk_f16(q_[0], q_[1]); kkwr.y = pk_f16(q_[2], q_[3]); kkwr.z = pk_f16(wr4[0], wr4[1]); kkwr.w = pk_f16(wr4[2], wr4[3]); \
                kkakd.x = pk_f16(kka4[0], kka4[1]); kkakd.y = pk_f16(kka4[2], kka4[3]); kkakd.z = pk_f16(kd4[0], kd4[1]); kkakd.w = pk_f16(kd4[2], kd4[3]); \
                *(LAS f32x4*)(bp + 16 * kq) = w4; *(LAS u32x4*)(bp + 256 + 16 * kq) = kkwr; *(LAS u32x4*)(bp + 512 + 16 * kq) = kkakd; \
                *(LAS f32x4*)(bp + 768 + 16 * kq) = (f32x4){vv, vv * c2 * 0.0625f, c1 * 0.0625f, 0.f}; } } while (0)
            SC_LOAD(0); SC_CONV(0); SC_LOAD(1);
            SCAN_BAR();
            for (int c = 0; c < SC_NCH; ++c) {
                if (c + 1 < SC_NCH) { SC_CONV((c + 1) & 1); }
                if (c + 2 < SC_NCH) { SC_LOAD(c + 2); }
                SCAN_BAR();
            }
#undef SC_LOAD
#undef SC_CONV
        } else {
            const int j = lane & 15, rr_ = lane >> 4, row = rg * 16 + wid * 4 + rr_;
            float st[4] = {0.f, 0.f, 0.f, 0.f};
            float pacc[16];
            const unsigned lbase = (unsigned)(size_t)lds;
            const long ystep = dir ? -512 : 512;
            SCAN_BAR();
            for (int c = 0; c < SC_NCH; ++c) {
                const unsigned cb = lbase + (c & 1) * SC_BUF;
                const unsigned bp = cb + 16 * j, vp = cb + 768 + 16 * (wid * 4 + rr_);
                const int sg = c * SC_CH + j; const int t = dir ? (T_ - 1 - sg) : sg;
                bf16_t* const yrow = YSg + (tokbase + t) * 512 + ch0 + row;
                ScanOps A, B;
                scan_ld<0>(A, bp, vp);
                scan_pair<0>(st, pacc, A, B, bp, vp, j, yrow, ystep);
                asm volatile("" : "+v"(st[0]), "+v"(st[1]), "+v"(st[2]), "+v"(st[3]));
                SCAN_BAR();
            }
        }
    }
}

__device__ __forceinline__ void combine_phase(const Params& p, const int tid) {
    const int lane = tid & 63, wid = tid >> 6;
    const int gw = blockIdx.x * 8 + wid, nw = gridDim.x * 8;
    unsigned char* ws = p.ws;
    const int c0 = lane * 8;
    const bf16_t* Y0 = (const bf16_t*)(ws + WS_YS0); const bf16_t* Y1 = (const bf16_t*)(ws + WS_YS1);
    const bf16_t* Rg = (const bf16_t*)(ws + WS_R); const bf16_t* Kg = (const bf16_t*)(ws + WS_K); const bf16_t* Vg = (const bf16_t*)(ws + WS_V);
    const bf16_t* A0 = (const bf16_t*)(ws + WS_OUT5 + 2 * SZ_TOK512); const bf16_t* A1 = (const bf16_t*)(ws + WS_OUT5 + 3 * SZ_TOK512); const bf16_t* Gg = (const bf16_t*)(ws + WS_OUT5 + 4 * SZ_TOK512);
    bf16_t* YM = (bf16_t*)(ws + WS_YMIX);
    float gnw[8], gnb[8], rk[8], ka[8];
#pragma unroll
    for (int q = 0; q < 8; ++q) { gnw[q] = p.in[21][c0 + q]; gnb[q] = p.in[22][c0 + q]; rk[q] = p.in[20][c0 + q]; ka[q] = p.in[19][c0 + q]; }
    u32x4 cur[8], nxt[8];
#define CMB_LOAD(dst, tk) do { const size_t o_ = (size_t)(tk) * 512 + c0; dst[0] = *(const u32x4*)(Y0 + o_); dst[1] = *(const u32x4*)(Y1 + o_); dst[2] = *(const u32x4*)(Rg + o_); dst[3] = *(const u32x4*)(Kg + o_); \
        dst[4] = *(const u32x4*)(Vg + o_); dst[5] = *(const u32x4*)(Gg + o_); dst[6] = *(const u32x4*)(A0 + o_); dst[7] = *(const u32x4*)(A1 + o_); } while (0)
    if (gw < M_) CMB_LOAD(cur, gw);
    for (int tok = gw; tok < M_; tok += nw) {
        if (tok + nw < M_) CMB_LOAD(nxt, tok + nw);
        float y0[8], y1[8], r[8], k[8], v[8], a0[8], a1[8], g[8];
        unpack8_bf(cur[0], y0); unpack8_bf(cur[1], y1); unpack8_bf(cur[2], r); unpack8_bf(cur[3], k); unpack8_bf(cur[4], v); unpack8_bf(cur[5], g);
        unpack8_h(cur[6], a0); unpack8_h(cur[7], a1);
        float y[8], s = 0.f, bs = 0.f;
#pragma unroll
        for (int q = 0; q < 8; ++q) { y[q] = y0[q] + y1[q]; s += y[q]; bs += r[q] * k[q] * rk[q] * (2.0f + (a0[q] + a1[q] - 2.0f) * ka[q]); }
        s = sum8(s); bs = sum8(bs);
        const float mean = s * (1.0f / 64.0f);
        float qv = 0.f;
#pragma unroll
        for (int q = 0; q < 8; ++q) { y[q] -= mean; qv += y[q] * y[q]; }
        qv = sum8(qv);
        const float rstd = __builtin_amdgcn_rsqf(qv * (1.0f / 64.0f) + 64e-5f);
        float o8[8];
#pragma unroll
        for (int q = 0; q < 8; ++q) o8[q] = ((y[q] * rstd) * gnw[q] + gnb[q] + bs * v[q]) * g[q];
        *(u32x4*)(YM + (size_t)tok * 1024 + 512 + c0) = pack8_bf(o8);
#pragma unroll
        for (int q = 0; q < 8; ++q) cur[q] = nxt[q];
    }
#undef CMB_LOAD
}

#define XB_TMO      128
#define XB_XCNT(j)  (256  + 64 * (j))
#define XB_XSUB(j)  (1280 + 64 * (j))
#define XB_XGEN(j)  (2304 + 64 * (j))
#define XB_TOP      3328
#define XB_TOPGEN   3392
#define XCD_BAR_WORDS 3456
#define XB_SPIN_CAP (1u << 18)

__device__ __forceinline__ unsigned xb_ld(unsigned* p)              { return __hip_atomic_load(p, __ATOMIC_RELAXED, __HIP_MEMORY_SCOPE_AGENT); }
__device__ __forceinline__ unsigned xb_add(unsigned* p, unsigned v) { return __hip_atomic_fetch_add(p, v, __ATOMIC_RELAXED, __HIP_MEMORY_SCOPE_AGENT); }
__device__ __forceinline__ unsigned xb_xcc_id() { return (unsigned)__builtin_amdgcn_s_getreg((3 << 11) | 20) & 0xFu; }
#define XB_SPIN(cond, bar) do { unsigned _sp = 0; while (cond) { __builtin_amdgcn_s_sleep(1); \
    if ((++_sp & 255u) == 0u) { if (xb_ld(&(bar)[XB_TMO])) break; if (_sp > XB_SPIN_CAP) { atomicAdd(&(bar)[XB_TMO], 1u); break; } } } } while (0)

struct XcdBarrier {
    unsigned* bar; unsigned x;
    volatile LAS unsigned* st;
};

__device__ __forceinline__ XcdBarrier xcd_barrier_post(unsigned* bar, volatile LAS unsigned* st) {
    XcdBarrier b; b.bar = bar; b.x = xb_xcc_id(); b.st = st;
    if (threadIdx.x == 0) (void)xb_add(&bar[XB_XCNT(b.x)], 1u);
    return b;
}
__device__ __forceinline__ void xcd_barrier_complete(unsigned* bar, unsigned x, unsigned& nloc, unsigned& nx) {
    const unsigned G = gridDim.x * gridDim.y * gridDim.z;
    unsigned sum, cnt, mine, sp = 0u;
    for (;;) {
        sum = 0u; cnt = 0u; mine = 0u;
#pragma unroll
        for (unsigned j = 0; j < 16; ++j) { const unsigned c = xb_ld(&bar[XB_XCNT(j)]); sum += c; cnt += (c > 0u) ? 1u : 0u; mine = (j == x) ? c : mine; }
        if (sum == G) break;
        __builtin_amdgcn_s_sleep(1);
        if ((++sp & 255u) == 0u) { if (xb_ld(&bar[XB_TMO])) break; if (sp > XB_SPIN_CAP) { atomicAdd(&bar[XB_TMO], 1u); break; } }
    }
    nloc = mine > 0u ? mine : 1u; nx = cnt > 0u ? cnt : 1u;
}

__device__ __forceinline__ void xcd_barrier(const XcdBarrier& b) {
    asm volatile("s_waitcnt vmcnt(0)" ::: "memory");
    __syncthreads();
    if (threadIdx.x == 0) {
        unsigned* bar = b.bar;
        __builtin_amdgcn_s_waitcnt(0);
        unsigned nloc = b.st[0], nx = b.st[1];
        if (nloc == 0u) { xcd_barrier_complete(bar, b.x, nloc, nx); b.st[0] = nloc; b.st[1] = nx; }
        const unsigned old = xb_add(&bar[XB_XSUB(b.x)], 1u);
        const unsigned gen = old / nloc;
        if (old + 1u == (gen + 1u) * nloc) {
            __builtin_amdgcn_fence(__ATOMIC_RELEASE, "agent");
            asm volatile("s_waitcnt vmcnt(0)" ::: "memory");
            const unsigned og = xb_add(&bar[XB_TOP], 1u);
            const unsigned tg = og / nx;
            if (og + 1u == (tg + 1u) * nx) xb_add(&bar[XB_TOPGEN], 1u);
            else XB_SPIN(xb_ld(&bar[XB_TOPGEN]) == tg, bar);
            __builtin_amdgcn_fence(__ATOMIC_ACQUIRE, "agent");
            xb_add(&bar[XB_XGEN(b.x)], 1u);
            asm volatile("s_waitcnt vmcnt(0)" ::: "memory");
        } else {
            XB_SPIN(xb_ld(&bar[XB_XGEN(b.x)]) == gen, bar);
            __builtin_amdgcn_fence(__ATOMIC_ACQUIRE, "agent");
            asm volatile("s_waitcnt vmcnt(0)" ::: "memory");
        }
    }
    __syncthreads();
}

#ifndef PROBE_MASK
#define PROBE_MASK 0
#endif
__global__ void __launch_bounds__(NTHREADS, 2) fwd_kernel(Params p) {
    extern __shared__ __attribute__((aligned(16))) unsigned char lds_raw[];
    LAS unsigned char* lds = (LAS unsigned char*)lds_raw;
    unsigned char* ws = p.ws;
    float* mod = (float*)(ws + WS_MOD); float* fmod = (float*)(ws + WS_FMOD);
    bf16_t* H = (bf16_t*)(ws + WS_H);
    if (threadIdx.x < 4) ((LAS unsigned*)(lds + 131072))[threadIdx.x] = 0u;
    __syncthreads();
    XcdBarrier bar; bar.bar = (unsigned*)(ws + WS_BAR); bar.x = 0; bar.st = (volatile LAS unsigned*)(lds + 131072);
    if (p.coop) bar = xcd_barrier_post((unsigned*)(ws + WS_BAR), (volatile LAS unsigned*)(lds + 131072));
    for (int ph = p.ph_lo; ph < p.ph_hi; ++ph) {
        for (int rep = 0; rep < (((PROBE_MASK >> ph) & 1) ? 2 : 1); ++rep) {
        if (rep) __syncthreads();
        int tid = threadIdx.x; asm volatile("" : "+v"(tid));
        switch (ph) {
            case 0: p0_prologue(p, lds, tid); break;
            case 1: modulate_phase<false>(p.in[0], p.in[4], mod + 0, mod + 1024, 9216, H, nullptr, tid); break;
            case 4: modulate_phase<false>(p.out, p.in[8], mod + 3072, mod + 4096, 9216, H, nullptr, tid); break;
            case 12: modulate_phase<false>(p.out, p.in[24], mod + 6144, mod + 7168, 9216, H, nullptr, tid); break;
            case 15: modulate_phase<true>(p.out, p.in[30], fmod + 0, fmod + 1024, 2048, nullptr, p.out, tid, H, mod + 8192); break;
            case 7: prep_phase(p, tid); break;
            case 9: scan_phase(p, lds, tid); break;
            case 10: combine_phase(p, tid); break;
            default: {
                pg8::Gemm g; pg8::EpiGen E;
                E.mode = 0; E.O = nullptr; E.ldo = 0; E.base = nullptr; E.out = nullptr; E.gate = nullptr; E.gscale = 1.f; E.w0 = p.in[13]; E.a0 = p.in[15];
                g.M = M_;
                switch (ph) {
                    case 2: g.A = H; g.Bt = (const bf16_t*)(ws + WS_WGU1); g.N = 5632; g.K = 1024; E.mode = 1; E.O = (bf16_t*)(ws + WS_HID); E.ldo = 2816; break;
                    case 3: g.A = (const bf16_t*)(ws + WS_HID); g.Bt = (const bf16_t*)(ws + WS_WD1); g.N = 1024; g.K = 2816; E.mode = 2; E.base = p.in[0]; E.out = p.out; E.gate = mod + 2048; E.gscale = 0.5f; break;
                    case 5: g.A = H; g.Bt = (const bf16_t*)(ws + WS_WINC); g.N = 1536; g.K = 1024; E.mode = 0; E.O = (bf16_t*)(ws + WS_PROJC); E.ldo = 1536; break;
                    case 6: g.A = H; g.Bt = (const bf16_t*)(ws + WS_WINR); g.N = 1792; g.K = 1024; E.mode = 0; E.O = (bf16_t*)(ws + WS_PROJR); E.ldo = 1792; break;
                    case 8: g.A = (const bf16_t*)(ws + WS_AP); g.Bt = (const bf16_t*)(ws + WS_WLORA); g.N = 2560; g.K = 256; E.mode = 3; E.O = (bf16_t*)(ws + WS_OUT5); E.ldo = 512; break;
                    case 11: g.A = (const bf16_t*)(ws + WS_YMIX); g.Bt = (const bf16_t*)(ws + WS_WOUT); g.N = 1024; g.K = 1024; E.mode = 2; E.base = p.out; E.out = p.out; E.gate = mod + 5120; E.gscale = 1.0f; break;
                    case 13: g.A = H; g.Bt = (const bf16_t*)(ws + WS_WGU2); g.N = 5632; g.K = 1024; E.mode = 1; E.O = (bf16_t*)(ws + WS_HID); E.ldo = 2816; break;
                    default: g.A = (const bf16_t*)(ws + WS_HID); g.Bt = (const bf16_t*)(ws + WS_WD2); g.N = 1024; g.K = 2816; E.mode = 0; E.O = H; E.ldo = 1024; break;
                }
                pg8::StaticOrder S; S.init(g.M, g.N, (int)gridDim.x, (int)blockIdx.x);
                pg8::gemm_phase<pg8::EpiGen, pg8::StaticOrder>(lds, g, S, E, tid);
            } break;
        }
        }
        if (ph + 1 < p.ph_hi) {
            if (ph == 5) __syncthreads();
            else if (p.pad != 0) cg::this_grid().sync();
            else xcd_barrier(bar);
        }
    }
}

constexpr int N_PHASES = 16;
#ifndef ONE_LAUNCH
#define ONE_LAUNCH 1
#endif
extern "C" void kernel_launch(void* const* d_in, const int* in_sizes, int n_in, void* d_out, int out_size, void* d_ws, size_t ws_size, hipStream_t stream) {
    static int grid = 0;
    if (grid == 0) {
        int dev = 0, cus = 0, per_cu = 0;
        hipGetDevice(&dev);
        hipDeviceGetAttribute(&cus, hipDeviceAttributeMultiprocessorCount, dev);
        hipFuncSetAttribute((const void*)fwd_kernel, hipFuncAttributeMaxDynamicSharedMemorySize, LDS_BYTES);
        hipOccupancyMaxActiveBlocksPerMultiprocessor(&per_cu, (const void*)fwd_kernel, NTHREADS, LDS_BYTES);
        if (per_cu < 1) per_cu = 1;
        grid = cus * 1;
        if (grid <= 0) grid = 256;
        if (ws_size < WS_END) fprintf(stderr, "kernel_launch: workspace too small: %zu < %zu\n", ws_size, (size_t)WS_END);
        if (n_in != 31) fprintf(stderr, "kernel_launch: expected 31 inputs, got %d\n", n_in);
        (void)hipGetLastError();
    }
    Params p{};
    for (int i = 0; i < 31; ++i) p.in[i] = (const float*)d_in[i];
    p.out = (float*)d_out; p.ws = (unsigned char*)d_ws; p.pad = 0;
#if ONE_LAUNCH
    (void)hipMemsetAsync((char*)d_ws + WS_BAR, 0, 16384, stream);
    p.ph_lo = 0; p.ph_hi = N_PHASES; p.coop = 1;
    void* args[] = {&p};
    hipError_t e = hipLaunchCooperativeKernel((const void*)fwd_kernel, dim3(grid), dim3(NTHREADS), args, LDS_BYTES, stream);
    if (e != hipSuccess) fprintf(stderr, "cooperative launch failed: %s (grid %d)\n", hipGetErrorString(e), grid);
#else
    p.coop = 0;
    for (int ph = 0; ph < N_PHASES; ++ph) {
        p.ph_lo = ph; p.ph_hi = ph + 1;
        hipLaunchKernelGGL(fwd_kernel, dim3(grid), dim3(NTHREADS), LDS_BYTES, stream, p);
    }
#endif
}
```
